# Optimizing an MI355X kernel written in HIP

```python
import math
import jax, jax.numpy as jnp
from jax import lax
import numpy as np

D_MODEL = 1024
BATCH = 8
SEQ = 2048
DEPTH = 2
DEC_BATCH = 128
DEC_SEQ = 4
PAST_LEN = 16384
PAGE_SIZE = 128

MIX_WIDTH = D_MODEL
SSM_WIDTH = MIX_WIDTH // 2
GMLP_WIDTH = MIX_WIDTH - SSM_WIDTH
SSM_GROUP = 16
SSM_GROUPS = SSM_WIDTH // SSM_GROUP
SSM_STATE = 64
CHUNK = 128
GMLP_HEADS = 4
GMLP_HEAD_DIM = GMLP_WIDTH // GMLP_HEADS
PLE_DIM = 256
D_FF = 4 * D_MODEL
IN_WIDTH = SSM_WIDTH + 2 * GMLP_WIDTH
EPS = 1e-6
DT_MIN = 1e-3
DT_MAX = 1e-1
LAM_RE_MAX = -1e-4

kernel_name = "hymba_s5_gmlp_decoder_step"


def rmsnorm(x, g):
    xf = x.astype(jnp.float32)
    r = lax.rsqrt(jnp.mean(xf * xf, axis=-1, keepdims=True) + EPS)
    return (xf * r * g.astype(jnp.float32)).astype(x.dtype)


def layernorm(x, g, b):
    xf = x.astype(jnp.float32)
    mu = jnp.mean(xf, axis=-1, keepdims=True)
    xc = xf - mu
    r = lax.rsqrt(jnp.mean(xc * xc, axis=-1, keepdims=True) + EPS)
    return (xc * r * g.astype(jnp.float32) + b.astype(jnp.float32)).astype(x.dtype)


def _combine(e1, e2):
    a1r, a1i, b1r, b1i = e1
    a2r, a2i, b2r, b2i = e2
    return (a2r * a1r - a2i * a1i,
            a2r * a1i + a2i * a1r,
            a2r * b1r - a2i * b1i + b2r,
            a2r * b1i + a2i * b1r + b2i)


def s5_scan(u, h0_re, h0_im, lam_re, lam_im, log_dt, b_re, b_im, c_re, c_im, d_skip):
    f32 = jnp.float32
    lr = jnp.minimum(lam_re.astype(f32), LAM_RE_MAX)
    li = lam_im.astype(f32)
    dt = jnp.exp(log_dt.astype(f32))[:, None]
    mag = jnp.exp(lr * dt)
    abr = mag * jnp.cos(li * dt)
    abi = mag * jnp.sin(li * dt)
    den = lr * lr + li * li
    nr = abr - 1.0
    ni = abi
    qr = (nr * lr + ni * li) / den
    qi = (ni * lr - nr * li) / den
    br = b_re.astype(f32)
    bi = b_im.astype(f32)
    bbr = qr[..., None] * br - qi[..., None] * bi
    bbi = qr[..., None] * bi + qi[..., None] * br
    n, seq_len, _ = u.shape
    ug = u.astype(f32).reshape(n, seq_len, SSM_GROUPS, SSM_GROUP)
    bur = jnp.einsum('nlgh,gph->nlgp', ug, bbr)
    bui = jnp.einsum('nlgh,gph->nlgp', ug, bbi)
    ar = jnp.broadcast_to(abr, bur.shape)
    ai = jnp.broadcast_to(abi, bur.shape)
    acr, aci, hr, hi = lax.associative_scan(_combine, (ar, ai, bur, bui), axis=1)
    h0r = h0_re.astype(f32)[:, None]
    h0i = h0_im.astype(f32)[:, None]
    hr = hr + acr * h0r - aci * h0i
    hi = hi + acr * h0i + aci * h0r
    y = (jnp.einsum('nlgp,ghp->nlgh', hr, c_re.astype(f32))
         - jnp.einsum('nlgp,ghp->nlgh', hi, c_im.astype(f32)))
    y = y.reshape(n, seq_len, SSM_WIDTH) + d_skip.astype(f32) * u.astype(f32)
    return y.astype(u.dtype), hr[:, -1], hi[:, -1]


def chunk_mix(v, w_s, b_s):
    n, seq_len, _ = v.shape
    pad = (-seq_len) % CHUNK
    vp = jnp.pad(v, ((0, 0), (0, pad), (0, 0)))
    nc = (seq_len + pad) // CHUNK
    vr = vp.reshape(n, nc, CHUNK, GMLP_HEADS, GMLP_HEAD_DIM)
    mask = jnp.tril(jnp.ones((CHUNK, CHUNK), dtype=bool))
    w = jnp.where(mask[None], w_s, jnp.zeros_like(w_s))
    out = jnp.einsum('hts,ncshd->ncthd', w, vr) + b_s.T[None, None, :, :, None]
    return out.reshape(n, nc * CHUNK, GMLP_WIDTH)[:, :seq_len]


def block(h, p_i, h0r, h0i, w, i):
    a = rmsnorm(h, w['g_mix'][i])
    z = a @ w['w_in'][i]
    u_s = z[..., :SSM_WIDTH]
    zg = jax.nn.gelu(z[..., SSM_WIDTH:])
    u_g = zg[..., :GMLP_WIDTH]
    v_g = zg[..., GMLP_WIDTH:]
    y_s, hr, hi = s5_scan(u_s, h0r, h0i, w['lam_re'][i], w['lam_im'][i], w['log_dt'][i],
                          w['b_re'][i], w['b_im'][i], w['c_re'][i], w['c_im'][i], w['d_skip'][i])
    y_s = jax.nn.gelu(y_s)
    y_s = y_s * jax.nn.sigmoid(y_s @ w['w_glu'][i] + w['b_glu'][i])
    v_n = layernorm(v_g, w['g_v'][i], w['b_v'][i])
    y_g = u_g * chunk_mix(v_n, w['w_s'][i], w['b_s'][i])
    y = jnp.concatenate([rmsnorm(y_s, w['g_out_s'][i]), rmsnorm(y_g, w['g_out_g'][i])], axis=-1)
    h = h + y @ w['w_out'][i]
    f = rmsnorm(h, w['g_ffn'][i])
    h = h + jnp.square(jax.nn.relu(f @ w['w_up'][i])) @ w['w_down'][i]
    gate = jax.nn.sigmoid(rmsnorm(h, w['g_ple'][i]) @ w['w_ple_gate'][i])
    h = h + gate * (p_i @ w['w_ple'][i])
    return h, hr, hi, v_n


def setup_inputs(seed: int = 0) -> dict:
    key = jax.random.key(seed)
    ks = iter(jax.random.split(key, 40))
    f32 = jnp.float32

    def nrm(shape, scale):
        return jax.random.normal(next(ks), shape, f32) * scale

    n_idx = jnp.arange(SSM_STATE, dtype=f32)
    inp = {}
    inp['x_prompt'] = nrm((BATCH, SEQ, D_MODEL), 1.0)
    inp['x_sample'] = nrm((DEC_BATCH, DEC_SEQ, D_MODEL), 1.0)
    inp['state_ssm_re'] = nrm((DEPTH, DEC_BATCH, SSM_GROUPS, SSM_STATE), 0.3)
    inp['state_ssm_im'] = nrm((DEPTH, DEC_BATCH, SSM_GROUPS, SSM_STATE), 0.3)
    inp['p_prompt'] = nrm((DEPTH, BATCH, SEQ, PLE_DIM), 1.0)
    inp['p_sample'] = nrm((DEPTH, DEC_BATCH, DEC_SEQ, PLE_DIM), 1.0)
    inp['g_mix'] = 1.0 + nrm((DEPTH, D_MODEL), 0.02)
    inp['w_in'] = nrm((DEPTH, D_MODEL, IN_WIDTH), D_MODEL ** -0.5)
    inp['lam_re'] = -0.5 + nrm((DEPTH, SSM_GROUPS, SSM_STATE), 0.01)
    inp['lam_im'] = math.pi * n_idx + nrm((DEPTH, SSM_GROUPS, SSM_STATE), 0.01)
    inp['log_dt'] = jax.random.uniform(next(ks), (DEPTH, SSM_GROUPS), f32,
                                       math.log(DT_MIN), math.log(DT_MAX))
    inp['b_re'] = nrm((DEPTH, SSM_GROUPS, SSM_STATE, SSM_GROUP), (2.0 * SSM_GROUP) ** -0.5)
    inp['b_im'] = nrm((DEPTH, SSM_GROUPS, SSM_STATE, SSM_GROUP), (2.0 * SSM_GROUP) ** -0.5)
    inp['c_re'] = nrm((DEPTH, SSM_GROUPS, SSM_GROUP, SSM_STATE), (2.0 * SSM_STATE) ** -0.5)
    inp['c_im'] = nrm((DEPTH, SSM_GROUPS, SSM_GROUP, SSM_STATE), (2.0 * SSM_STATE) ** -0.5)
    inp['d_skip'] = nrm((DEPTH, SSM_WIDTH), 1.0)
    inp['w_glu'] = nrm((DEPTH, SSM_WIDTH, SSM_WIDTH), SSM_WIDTH ** -0.5)
    inp['b_glu'] = nrm((DEPTH, SSM_WIDTH), 0.02)
    inp['g_v'] = 1.0 + nrm((DEPTH, GMLP_WIDTH), 0.02)
    inp['b_v'] = nrm((DEPTH, GMLP_WIDTH), 0.02)
    inp['w_s'] = nrm((DEPTH, GMLP_HEADS, CHUNK, CHUNK), 0.5 * CHUNK ** -0.5)
    inp['b_s'] = 1.0 + nrm((DEPTH, GMLP_HEADS, CHUNK), 0.1)
    inp['g_out_s'] = 1.0 + nrm((DEPTH, SSM_WIDTH), 0.02)
    inp['g_out_g'] = 1.0 + nrm((DEPTH, GMLP_WIDTH), 0.02)
    inp['w_out'] = nrm((DEPTH, MIX_WIDTH, D_MODEL), MIX_WIDTH ** -0.5)
    inp['g_ffn'] = 1.0 + nrm((DEPTH, D_MODEL), 0.02)
    inp['w_up'] = nrm((DEPTH, D_MODEL, D_FF), D_MODEL ** -0.5)
    inp['w_down'] = nrm((DEPTH, D_FF, D_MODEL), D_FF ** -0.5)
    inp['g_ple'] = 1.0 + nrm((DEPTH, D_MODEL), 0.02)
    inp['w_ple_gate'] = nrm((DEPTH, D_MODEL, D_MODEL), D_MODEL ** -0.5)
    inp['w_ple'] = nrm((DEPTH, PLE_DIM, D_MODEL), PLE_DIM ** -0.5)
    inp['g_final'] = 1.0 + nrm((D_MODEL,), 0.02)
    return inp


def reference(x_prompt, x_sample, state_ssm_re, state_ssm_im, p_prompt, p_sample,
              g_mix, w_in, lam_re, lam_im, log_dt, b_re, b_im, c_re, c_im, d_skip,
              w_glu, b_glu, g_v, b_v, w_s, b_s, g_out_s, g_out_g, w_out,
              g_ffn, w_up, w_down, g_ple, w_ple_gate, w_ple, g_final):
    w = dict(g_mix=g_mix, w_in=w_in, lam_re=lam_re, lam_im=lam_im, log_dt=log_dt,
             b_re=b_re, b_im=b_im, c_re=c_re, c_im=c_im, d_skip=d_skip,
             w_glu=w_glu, b_glu=b_glu, g_v=g_v, b_v=b_v, w_s=w_s, b_s=b_s,
             g_out_s=g_out_s, g_out_g=g_out_g, w_out=w_out, g_ffn=g_ffn,
             w_up=w_up, w_down=w_down, g_ple=g_ple, w_ple_gate=w_ple_gate, w_ple=w_ple)
    h_p = x_prompt
    zeros_state = jnp.zeros((BATCH, SSM_GROUPS, SSM_STATE), jnp.float32)
    re_p, im_p = [], []
    for i in range(DEPTH):
        h_p, hr, hi, _ = block(h_p, p_prompt[i], zeros_state, zeros_state, w, i)
        re_p.append(hr)
        im_p.append(hi)
    y_prompt = rmsnorm(h_p, g_final)
    h_s = x_sample
    re_s, im_s, v_s = [], [], []
    for i in range(DEPTH):
        h_s, hr, hi, v_n = block(h_s, p_sample[i], state_ssm_re[i], state_ssm_im[i], w, i)
        re_s.append(hr)
        im_s.append(hi)
        v_s.append(v_n)
    y_sample = rmsnorm(h_s, g_final)
    ssm_re_prompt = jnp.stack(re_p)
    ssm_im_prompt = jnp.stack(im_p)
    ssm_re_sample = jnp.stack(re_s)
    ssm_im_sample = jnp.stack(im_s)
    v_sample = jnp.stack(v_s)
    return (y_prompt, y_sample, ssm_re_prompt, ssm_im_prompt, ssm_re_sample, ssm_im_sample, v_sample)
```

```cpp
#include <hip/hip_runtime.h>
#include <cstdio>
#include <cstdint>

namespace pg8 {
#define PG8_LAS __attribute__((address_space(3)))
typedef unsigned short bf16_t;
typedef short bf16x8 __attribute__((ext_vector_type(8)));
typedef float f32x4 __attribute__((ext_vector_type(4)));
typedef unsigned u32x4 __attribute__((ext_vector_type(4)));
constexpr int BM = 256, BK = 64, HALF = 128, HTB = HALF * BK * 2  , STAGE_BYTES = 8 * HTB, NXCD = 8, WGM = 8;
constexpr int XR_OFF = STAGE_BYTES + 9216;

__host__ __device__ __forceinline__ int lds_byte(int r, int c) { const int st = (r >> 4) * 2 + (c >> 5), rr = r & 15, cc = c & 31, ob = rr * 64 + cc * 2; return st * 1024 + (ob ^ (((ob >> 9) & 1) << 5)); }
__host__ __device__ __forceinline__ void stage_rc(int b, int& R, int& C) { const int st = b / 1024, sb = b % 1024, swz = sb ^ (((sb >> 9) & 1) << 5); R = (st >> 1) * 16 + swz / 64; C = (st & 1) * 32 + (swz % 64) / 2; }
__host__ __device__ __forceinline__ int perm32(int rho) { const int n = rho >> 4, i = rho & 15; return 8 * (i >> 2) + 4 * n + (i & 3); }

struct Unit { int pm, pn, ui; };
struct Gemm { const bf16_t* A; const bf16_t* Bt; int M, N, K; int lda = 0; int kblk = 0; int t0 = 0; const bf16_t* Ax = nullptr; int ldax = 0; };

struct StaticOrder {
    int nM, nN, nwg, G, c;
    __host__ __device__ __forceinline__ void init(int M, int N, int G_, int c_) { nM = M / BM; nN = N / BM; nwg = nM * nN; G = G_; c = c_; }
    __host__ __device__ __forceinline__ bool next(int i, Unit& u) const {
        const long L = (long)i * G + c; if (L >= nwg) return false;
        int wgid = (int)L; { const int q = nwg / NXCD, r = nwg % NXCD, xcd = wgid % NXCD, off = wgid / NXCD; wgid = (xcd < r ? xcd * (q + 1) : r * (q + 1) + (xcd - r) * q) + off; }
        const int nig = WGM * nN, gid = wgid / nig, fm = gid * WGM, gsz = (nM - fm) < WGM ? (nM - fm) : WGM;
        u.pm = fm + ((wgid % nig) % gsz); u.pn = (wgid % nig) / gsz; u.ui = i; return true;
    }
    __device__ __forceinline__ void a_ready(const Unit&) const {}
    __device__ __forceinline__ void done(const Unit&) const {}
};


#ifndef WT_STORES
#define WT_STORES 0
#endif
__device__ __forceinline__ unsigned cvt_pk_bf16(float lo, float hi) { unsigned r; asm volatile("v_cvt_pk_bf16_f32 %0, %1, %2" : "=v"(r) : "v"(lo), "v"(hi)); return r; }
typedef float f32x2 __attribute__((ext_vector_type(2)));

typedef unsigned u32x2 __attribute__((ext_vector_type(2)));
__device__ __forceinline__ void store16_wt(void* p, u32x4 v) {
#if WT_STORES
    asm volatile("global_store_dwordx4 %0, %1, off sc1\n\ts_nop 1" :: "v"(p), "v"(v) : "memory");
#else
    *(u32x4*)p = v;
#endif
}
constexpr float NORM_EPS = 1e-6f;
constexpr float LOG2E = 1.4426950408889634f;
__device__ __forceinline__ float bf_lo(unsigned w) { return __uint_as_float(w << 16); }
__device__ __forceinline__ float bf_hi(unsigned w) { return __uint_as_float(w & 0xffff0000u); }
__device__ __forceinline__ float sigmoid_f(float x) { return __builtin_amdgcn_rcpf(1.0f + __builtin_amdgcn_exp2f(-LOG2E * x)); }
__device__ __forceinline__ float gelu_tanh(float x) { const float u = 1.5957691216057308f * (x + 0.044715f * x * x * x); return x * sigmoid_f(u); }
__device__ __forceinline__ float rinv16(const float* ssq, int row, float inv_n) {
    const f32x4* p = (const f32x4*)(ssq + (size_t)row * 16);
    const f32x4 a = p[0], b = p[1], c = p[2], d = p[3];
    const float s = ((a[0] + a[1]) + (a[2] + a[3])) + ((b[0] + b[1]) + (b[2] + b[3])) + ((c[0] + c[1]) + (c[2] + c[3])) + ((d[0] + d[1]) + (d[2] + d[3]));
    return __builtin_amdgcn_rsqf(s * inv_n + NORM_EPS);
}

struct RtPre { f32x4 a, b, c, d; };
__device__ __forceinline__ RtPre rtpre_load(const float* ssq, int row) { const f32x4* p = (const f32x4*)(ssq + (size_t)row * 16); RtPre r; r.a = p[0]; r.b = p[1]; r.c = p[2]; r.d = p[3]; return r; }
__device__ __forceinline__ float rtpre_rinv(const RtPre& p, float inv_n) {
    const float s = ((p.a[0] + p.a[1]) + (p.a[2] + p.a[3])) + ((p.b[0] + p.b[1]) + (p.b[2] + p.b[3])) + ((p.c[0] + p.c[1]) + (p.c[2] + p.c[3])) + ((p.d[0] + p.d[1]) + (p.d[2] + p.d[3]));
    return __builtin_amdgcn_rsqf(s * inv_n + NORM_EPS); }
template <class Sched> __device__ __forceinline__ void rtab_hook(const Sched& S, const Unit& u0, const RtPre& pre, const float* ssq, PG8_LAS float* rt) {
    int t_ = threadIdx.x; asm volatile("" : "+v"(t_));
    if (t_ < 256) { const float r0 = rtpre_rinv(pre, 1.0f / 1024.0f); Unit u_;
        for (int i_ = 0; i_ < 8 && S.next(i_, u_); ++i_) { float r = r0; if (u_.pm != u0.pm) r = rinv16(ssq, u_.pm * 256 + t_, 1.0f / 1024.0f); rt[i_ * 256 + t_] = r; } }
}
template <int MODE> struct EpiAct {
    static constexpr bool PERM = true, AFTER_DRAIN = false, MIDSCALE = false, PREHOOK = (MODE == 0 || MODE == 1);
    bf16_t* O; int ldo; size_t seg_stride; int us_rows; const float* ssq; float* st; const bf16_t* aux; const float* bias; const PG8_LAS float* rtab;
    bf16_t* Ox = nullptr; int ldox = 0; int xrow0 = 0; RtPre pre = {};
    template <class Sched> __device__ __forceinline__ void prehook(const Sched& S, const Unit& u0) const { rtab_hook(S, u0, pre, ssq, (PG8_LAS float*)rtab); }
    __device__ __forceinline__ void xrows(const f32x4 (&ax)[2], const Unit& u, int wr, int wc, int fr, int fq) const {
        static_assert(MODE == 1 || MODE == 3, "extra rows: w_up and plain epilogues only");
        int upm = u.pm, upn = u.pn; asm volatile("" : "+s"(upm), "+s"(upn));
        const int xr = (upm >> 1) * 16 + fr, c0 = upn * BM + wr * HALF + wc * 32 + 8 * fq;
        f32x4 v0 = ax[0], v1 = ax[1];
        if (MODE == 1) { const float r = rinv16(ssq, xrow0 + xr, 1.0f / 1024.0f);
#pragma unroll
            for (int j = 0; j < 4; ++j) { const float a = fmaxf(v0[j] * r, 0.f), b = fmaxf(v1[j] * r, 0.f); v0[j] = a * a; v1[j] = b * b; } }
        u32x4 w; w.x = cvt_pk_bf16(v0[0], v0[1]); w.y = cvt_pk_bf16(v0[2], v0[3]); w.z = cvt_pk_bf16(v1[0], v1[1]); w.w = cvt_pk_bf16(v1[2], v1[3]);
        store16_wt(Ox + (size_t)xr * ldox + c0, w);
    }
    __device__ __forceinline__ void operator()(const f32x4 (&acc)[2][2][4][2], const Unit& u, int wr, int wc, int fr, int fq) const {
        int upm = u.pm, upn = u.pn; asm volatile("" : "+s"(upm), "+s"(upn));
        const int row0 = upm * BM + wr * 64 + fr;
        int seg = 0; bf16_t* base = O; int colt = upn * BM;
        if (MODE == 0) { seg = upn >> 1; base = O + (size_t)seg * seg_stride; colt = (upn & 1) * BM; }
        if (MODE == 1) { base = O + ((size_t)(upm * us_rows + upn) << 16) - (size_t)(upm * BM) * ldo; colt = 0; }
        const int col0 = colt + wc * 32 + 8 * fq;
        f32x4 bv[2][2];
#pragma unroll
        for (int bj = 0; bj < 2; ++bj)
#pragma unroll
            for (int n = 0; n < 2; ++n) bv[bj][n] = (MODE == 2) ? *(const f32x4*)(bias + col0 + bj * HALF + 4 * n) : (f32x4){0.f, 0.f, 0.f, 0.f};
        float rr[2][4];
#pragma unroll
        for (int ai = 0; ai < 2; ++ai)
#pragma unroll
            for (int m = 0; m < 4; ++m) { rr[ai][m] = 1.f; if (MODE == 0 || MODE == 1) rr[ai][m] = (u.ui < 8) ? rtab[u.ui * 256 + wr * 64 + fr + ai * HALF + m * 16] : rinv16(ssq, row0 + ai * HALF + m * 16, 1.0f / 1024.0f); }
        u32x4 yq[2][2];
        if (MODE == 2) {
#pragma unroll
            for (int bj = 0; bj < 2; ++bj) yq[0][bj] = *(const u32x4*)(aux + (size_t)row0 * 512 + col0 + bj * HALF); }
#pragma unroll
        for (int ai = 0; ai < 2; ++ai)
#pragma unroll
            for (int m = 0; m < 4; ++m) {
                const int row = row0 + ai * HALF + m * 16;
                const float r = rr[ai][m];
                float s1 = 0.f, s2 = 0.f;
                if (MODE == 2) { if (ai * 4 + m < 7) { const int gn = ai * 4 + m + 1, rown = row0 + (gn >> 2) * HALF + (gn & 3) * 16;
#pragma unroll
                    for (int bj = 0; bj < 2; ++bj) yq[gn & 1][bj] = *(const u32x4*)(aux + (size_t)rown * 512 + col0 + bj * HALF); } }
#pragma unroll
                for (int bj = 0; bj < 2; ++bj) {
                    f32x4 v0 = acc[ai][bj][m][0] * r, v1 = acc[ai][bj][m][1] * r;
                    if (MODE == 0) { if (seg != 0) {
#pragma unroll
                        for (int j = 0; j < 4; ++j) { v0[j] = gelu_tanh(v0[j]); v1[j] = gelu_tanh(v1[j]); } }
                        if (seg == 2) {
#pragma unroll
                            for (int j = 0; j < 4; ++j) { s1 += v0[j] + v1[j]; s2 += v0[j] * v0[j] + v1[j] * v1[j]; } } }
                    if (MODE == 1) {
#pragma unroll
                        for (int j = 0; j < 4; ++j) { const float a = fmaxf(v0[j], 0.f), b = fmaxf(v1[j], 0.f); v0[j] = a * a; v1[j] = b * b; } }
                    if (MODE == 2) {
                        const u32x4 yv = yq[(ai * 4 + m) & 1][bj];
                        const f32x4 b0 = bv[bj][0], b1 = bv[bj][1];
                        v0[0] = bf_lo(yv.x) * sigmoid_f(v0[0] + b0[0]); v0[1] = bf_hi(yv.x) * sigmoid_f(v0[1] + b0[1]);
                        v0[2] = bf_lo(yv.y) * sigmoid_f(v0[2] + b0[2]); v0[3] = bf_hi(yv.y) * sigmoid_f(v0[3] + b0[3]);
                        v1[0] = bf_lo(yv.z) * sigmoid_f(v1[0] + b1[0]); v1[1] = bf_hi(yv.z) * sigmoid_f(v1[1] + b1[1]);
                        v1[2] = bf_lo(yv.w) * sigmoid_f(v1[2] + b1[2]); v1[3] = bf_hi(yv.w) * sigmoid_f(v1[3] + b1[3]);
#pragma unroll
                        for (int j = 0; j < 4; ++j) s2 += v0[j] * v0[j] + v1[j] * v1[j];
                    }
                    u32x4 w; w.x = cvt_pk_bf16(v0[0], v0[1]); w.y = cvt_pk_bf16(v0[2], v0[3]); w.z = cvt_pk_bf16(v1[0], v1[1]); w.w = cvt_pk_bf16(v1[2], v1[3]);
                    if (MODE == 0 && seg == 0) { const int c = col0 + bj * HALF;
                        store16_wt(base + ((size_t)(c >> 4) * us_rows + row) * 16 + (c & 8), w); }
                    else store16_wt(base + (size_t)row * ldo + col0 + bj * HALF, w);
                }
                if (MODE == 0) { if (seg == 2) {
                    s1 += __shfl_xor(s1, 16); s1 += __shfl_xor(s1, 32); s2 += __shfl_xor(s2, 16); s2 += __shfl_xor(s2, 32);
                    if (fq == 0) { f32x2 o; o.x = s1; o.y = s2; *(f32x2*)(st + (size_t)row * 16 + ((upn & 1) * 4 + wc) * 2) = o; } } }
                if (MODE == 2) { s2 += __shfl_xor(s2, 16); s2 += __shfl_xor(s2, 32); if (fq == 0) st[(size_t)row * 8 + upn * 4 + wc] = s2; }
                asm volatile("" ::: "memory");
            }
    }
};

template <bool GATED, bool MID = false> struct EpiRes {
    static constexpr bool PREHOOK = GATED || MID;
    static constexpr bool PERM = true, AFTER_DRAIN = false, MIDSCALE = MID;
    __device__ __forceinline__ void midscale(f32x4 (&acc)[2][2][4][2], const Unit& u, int wr, int fr) const {
#pragma unroll
        for (int ai = 0; ai < 2; ++ai)
#pragma unroll
            for (int m = 0; m < 4; ++m) { const float s = rtab[u.ui * 512 + 256 + wr * 64 + fr + ai * HALF + m * 16];
#pragma unroll
                for (int bj = 0; bj < 2; ++bj)
#pragma unroll
                    for (int n = 0; n < 2; ++n) acc[ai][bj][m][n] = acc[ai][bj][m][n] * s; }
    }
    const bf16_t* hin; bf16_t* hb; float* ssq_out; const float* ssq_in; const bf16_t* pl; int dry; const PG8_LAS float* rtab; RtPre pre = {}; const float* gs = nullptr; const float* gq = nullptr; int gq_stride = 0;
    template <class Sched> __device__ __forceinline__ void prehook(const Sched& S, const Unit& u0) const {
        if constexpr (!MID) rtab_hook(S, u0, pre, ssq_in, (PG8_LAS float*)rtab);
        else { int t_ = threadIdx.x; asm volatile("" : "+v"(t_)); PG8_LAS float* rt = (PG8_LAS float*)rtab;
            if (t_ < 256) { Unit u_;
                for (int i_ = 0; i_ < 4 && S.next(i_, u_); ++i_) { f32x4 a = pre.a, b = pre.b; float q0 = pre.c[0], q1 = pre.c[1];
                    if (u_.pm != u0.pm) { const size_t row = (size_t)u_.pm * 256 + t_; a = *(const f32x4*)(gs + row * 8); b = *(const f32x4*)(gs + row * 8 + 4); q0 = gq[row]; q1 = gq[gq_stride + row]; }
                    const float rs = __builtin_amdgcn_rsqf((((a[0] + a[1]) + (a[2] + a[3])) + ((b[0] + b[1]) + (b[2] + b[3]))) * (1.0f / 512.0f) + NORM_EPS), rg = __builtin_amdgcn_rsqf((q0 + q1) * (1.0f / 512.0f) + NORM_EPS);
                    rt[i_ * 512 + t_] = rg; rt[i_ * 512 + 256 + t_] = rs * __builtin_amdgcn_rcpf(rg); } } }
    }
    __device__ __forceinline__ void operator()(const f32x4 (&acc)[2][2][4][2], const Unit& u, int wr, int wc, int fr, int fq) const {
        int upm = u.pm, upn = u.pn; asm volatile("" : "+s"(upm), "+s"(upn));
        const int row0 = upm * BM + wr * 64 + fr, col0 = upn * BM + wc * 32 + 8 * fq;
        constexpr int NPF = 2;
#pragma unroll
        for (int ai = 0; ai < 2; ++ai)
#pragma unroll
            for (int mp = 0; mp < 4 / NPF; ++mp) {
                u32x4 hv[NPF][2]; u32x4 pv[NPF][2];
#pragma unroll
                for (int mm = 0; mm < NPF; ++mm) { const int row = row0 + ai * HALF + (NPF * mp + mm) * 16;
#pragma unroll
                    for (int bj = 0; bj < 2; ++bj) { const size_t off = (size_t)row * 1024 + col0 + bj * HALF; hv[mm][bj] = *(const u32x4*)(hin + off); if (GATED) pv[mm][bj] = *(const u32x4*)(pl + off); } }
#pragma unroll
                for (int mm = 0; mm < NPF; ++mm) { const int m = NPF * mp + mm, row = row0 + ai * HALF + m * 16;
                    float r = 1.f; if (GATED) r = (u.ui < 8) ? rtab[u.ui * 256 + wr * 64 + fr + ai * HALF + m * 16] : rinv16(ssq_in, row, 1.0f / 1024.0f);
                    if (MID) r = rtab[u.ui * 512 + wr * 64 + fr + ai * HALF + m * 16];
                    float sq = 0.f;
#pragma unroll
                    for (int bj = 0; bj < 2; ++bj) { const size_t off = (size_t)row * 1024 + col0 + bj * HALF;
                        f32x4 a0 = acc[ai][bj][m][0], a1 = acc[ai][bj][m][1]; const u32x4 hq = hv[mm][bj];
                        f32x4 x0 = (f32x4){bf_lo(hq.x), bf_hi(hq.x), bf_lo(hq.y), bf_hi(hq.y)}, x1 = (f32x4){bf_lo(hq.z), bf_hi(hq.z), bf_lo(hq.w), bf_hi(hq.w)};
                        if (MID) { a0 = a0 * r; a1 = a1 * r; }
                        if (GATED) { const u32x4 p4 = pv[mm][bj];
                            a0[0] = sigmoid_f(a0[0] * r) * bf_lo(p4.x); a0[1] = sigmoid_f(a0[1] * r) * bf_hi(p4.x); a0[2] = sigmoid_f(a0[2] * r) * bf_lo(p4.y); a0[3] = sigmoid_f(a0[3] * r) * bf_hi(p4.y);
                            a1[0] = sigmoid_f(a1[0] * r) * bf_lo(p4.z); a1[1] = sigmoid_f(a1[1] * r) * bf_hi(p4.z); a1[2] = sigmoid_f(a1[2] * r) * bf_lo(p4.w); a1[3] = sigmoid_f(a1[3] * r) * bf_hi(p4.w); }
                        x0 = x0 + a0; x1 = x1 + a1;
                        u32x4 w; w.x = cvt_pk_bf16(x0[0], x0[1]); w.y = cvt_pk_bf16(x0[2], x0[3]); w.z = cvt_pk_bf16(x1[0], x1[1]); w.w = cvt_pk_bf16(x1[2], x1[3]);
                        if (!dry) *(u32x4*)(hb + off) = w; else asm volatile("" :: "v"(w.x), "v"(w.y), "v"(w.z), "v"(w.w));
                        sq += ((x0[0] * x0[0] + x0[1] * x0[1]) + (x0[2] * x0[2] + x0[3] * x0[3])) + ((x1[0] * x1[0] + x1[1] * x1[1]) + (x1[2] * x1[2] + x1[3] * x1[3])); }
                    sq += __shfl_xor(sq, 16); sq += __shfl_xor(sq, 32);
                    if (fq == 0 && !dry) ssq_out[(size_t)row * 16 + upn * 4 + wc] = sq; }
                asm volatile("" ::: "memory");
            }
    }
};
struct RevOrder : StaticOrder {
    int nr, rot;
    __device__ __forceinline__ void init_rev(int M, int N, int G_, int c_) { init(M, N, G_, c_); nr = (c < nwg) ? (nwg - c + G - 1) / G : 0; rot = (c >> 3) & 3; if (rot >= nr) rot = 0; }
    __device__ __forceinline__ bool next(int i, Unit& u) const { if (i >= nr) return false; int j = nr - 1 - i + rot; if (j >= nr) j -= nr; const bool ok = StaticOrder::next(j, u); u.ui = i; return ok; }
};
struct PanelOrder {
    int nM, c;
    __device__ __forceinline__ bool next(int i, Unit& u) const { if (c >= nM || i >= 2) return false; u.pm = c; u.pn = i; u.ui = i; return true; }
    __device__ __forceinline__ void a_ready(const Unit&) const {}
    __device__ __forceinline__ void done(const Unit&) const {}
};

template <class Epi, class Sched, bool ALIGN_EPI = false, bool SP2 = false, bool DRAIN = true, bool XR = false>
__device__ __forceinline__ void gemm_phase(PG8_LAS unsigned char* lds, const Gemm g, const Sched& S, const Epi& E) {
    int tid_ = threadIdx.x; asm volatile("" : "+v"(tid_));
    const int tid = tid_, wid = __builtin_amdgcn_readfirstlane(tid >> 6), lane = tid & 63, wr = wid >> 2, wc = wid & 3, fr = lane & 15, fq = lane >> 4;
    const int K = g.K, nt = K / BK, lda = g.lda ? g.lda : K;
    unsigned voffA[2], voffB[2];
#pragma unroll
    for (int i = 0; i < 2; ++i) { int R, C; stage_rc(tid * 16 + i * 8192, R, C); const int Rb = Epi::PERM ? ((R & ~31) + perm32(R & 31)) : R;
        voffA[i] = (unsigned)(R * lda + C) * 2u; voffB[i] = (unsigned)(Rb * K + C) * 2u; }
    const size_t kstep = (size_t)(BK * 2);
    const size_t hstep = (size_t)HALF * K * 2;
    const size_t hstepA = (size_t)HALF * lda * 2;
    const int t0 = g.t0, ntm = nt - 1;
    const size_t kblkA = g.kblk ? (size_t)g.kblk : 4 * kstep;
    const size_t tstep = 2 * hstep;
    const unsigned ldsw = (unsigned)wid * 1024u;
    const int aoff = lds_byte(wr * 64 + fr, fq * 8), boff = lds_byte(wc * 32 + fr, fq * 8);
    static_assert(!XR || SP2, "extra rows: SP2 body only");
    unsigned voffX = 0; const int aoffx = lds_byte(fr, fq * 8);
    if constexpr (XR) { int R, C; stage_rc(wid * 256 + (lane & 15) * 16, R, C); voffX = (unsigned)(R * g.ldax + C) * 2u; }
    const size_t xstep = (size_t)16 * (XR ? g.ldax : 0) * 2;
#define PG8_KOA(x) ((size_t)((((x) + t0) & ntm) >> 2) * kblkA + (size_t)((((x) + t0) & ntm) & 3) * kstep)
#define PG8_KOB(x) ((size_t)(((x) + t0) & ntm) * kstep)
#define PG8_KOX(x) ((size_t)(((x) + t0) & ntm) * kstep)
#define PG8_STAGEX(b, gbase) do { if constexpr (XR) { if (lane < 16) __builtin_amdgcn_global_load_lds((const unsigned*)((const char*)(gbase) + voffX), (PG8_LAS unsigned*)(lds + XR_OFF + (b) * 2048 + wid * 256), 16, 0, 0); } } while (0)
#define PG8_LDX(b) do { if constexpr (XR) { _Pragma("unroll") for (int k = 0; k < 2; ++k) Ax_[k] = *(const PG8_LAS bf16x8*)(lds + XR_OFF + (b) * 2048 + aoffx + k * 1024); } } while (0)
#define PG8_MMAX_(Bt) do { _Pragma("unroll") for (int n = 0; n < 2; ++n) _Pragma("unroll") for (int k = 0; k < 2; ++k) accx[n] = __builtin_amdgcn_mfma_f32_16x16x32_bf16(Bt[n][k], Ax_[k], accx[n], 0, 0, 0); } while (0)
#define PG8_MMAX() do { if constexpr (XR) { if (hasx) { if (wr == 0) PG8_MMAX_(B0); else PG8_MMAX_(B1); } } } while (0)
#define PG8_WAIT_LOOP() do { if constexpr (XR) PG8_WAIT_V(9); else PG8_WAIT_V(8); } while (0)
#define PG8_SA(b, h) (((b) * 2 + (h)) * HTB)
#define PG8_SB(b, h) ((4 + (b) * 2 + (h)) * HTB)
#define PG8_STAGE(bufoff, gbase, voff) do { _Pragma("unroll") for (int _i = 0; _i < 2; ++_i) \
        __builtin_amdgcn_global_load_lds((const unsigned*)((const char*)(gbase) + (voff)[_i]), (PG8_LAS unsigned*)(lds + (bufoff) + ldsw + _i * 8192), 16, 0, 0); } while (0)
#define PG8_LDA(dst, b, h) do { _Pragma("unroll") for (int m = 0; m < 4; ++m) _Pragma("unroll") for (int k = 0; k < 2; ++k) dst[m][k] = *(const PG8_LAS bf16x8*)(lds + PG8_SA(b, h) + aoff + m * 2048 + k * 1024); } while (0)
#define PG8_LDB(dst, b, h) do { _Pragma("unroll") for (int n = 0; n < 2; ++n) _Pragma("unroll") for (int k = 0; k < 2; ++k) dst[n][k] = *(const PG8_LAS bf16x8*)(lds + PG8_SB(b, h) + boff + n * 2048 + k * 1024); } while (0)
#define PG8_MMA(ai, bj, At, Bt) do { __builtin_amdgcn_s_setprio(1); _Pragma("unroll") for (int m = 0; m < 4; ++m) _Pragma("unroll") for (int n = 0; n < 2; ++n) _Pragma("unroll") for (int k = 0; k < 2; ++k) \
        acc[ai][bj][m][n] = __builtin_amdgcn_mfma_f32_16x16x32_bf16(Bt[n][k], At[m][k], acc[ai][bj][m][n], 0, 0, 0); __builtin_amdgcn_s_setprio(0); } while (0)
#define PG8_WAIT_V(n) asm volatile("s_waitcnt vmcnt(" #n ")" ::: "memory")
#define PG8_WAIT_L(n) asm volatile("s_waitcnt lgkmcnt(" #n ")" ::: "memory")
#define PG8_BAR __builtin_amdgcn_s_barrier()
#define PG8_SCHED __builtin_amdgcn_sched_barrier(0)
    Unit cur, nxt; int ui = 0;
    if (!S.next(0, cur)) return;
    f32x4 acc[2][2][4][2];
#pragma unroll
    for (int a = 0; a < 2; ++a)
#pragma unroll
        for (int b = 0; b < 2; ++b)
#pragma unroll
            for (int m = 0; m < 4; ++m)
#pragma unroll
                for (int n = 0; n < 2; ++n) acc[a][b][m][n] = (f32x4){0.f, 0.f, 0.f, 0.f};
    bf16x8 At[4][2], B0[2][2], B1[2][2];
    f32x4 accx[2] = {(f32x4){0.f, 0.f, 0.f, 0.f}, (f32x4){0.f, 0.f, 0.f, 0.f}}; bf16x8 Ax_[2]; const int xnh = (g.N / BM) >> 1; bool hasx = XR && (((cur.pm & 1) == 0) == (cur.pn < xnh));
    const char* cX = XR ? (const char*)g.Ax + (size_t)(cur.pm >> 1) * xstep : nullptr;
    const char* cA = (const char*)g.A + (size_t)cur.pm * tstep; const char* cB = (const char*)g.Bt + (size_t)cur.pn * tstep;
    const size_t kx0 = PG8_KOX(0);
    const size_t ka0 = PG8_KOA(0), kb0 = PG8_KOB(0);
    S.a_ready(cur);
    if constexpr (SP2) {
        PG8_STAGE(PG8_SB(0, 0), cB + kb0, voffB); PG8_STAGE(PG8_SB(0, 1), cB + kb0 + hstep, voffB); PG8_STAGE(PG8_SA(0, 0), cA + ka0, voffA); PG8_STAGEX(0, cX + kx0); PG8_STAGE(PG8_SA(0, 1), cA + ka0 + hstepA, voffA);
        PG8_STAGE(PG8_SB(1, 0), cB + kb0 + kstep, voffB); PG8_STAGE(PG8_SA(1, 0), cA + ka0 + kstep, voffA); PG8_STAGE(PG8_SB(1, 1), cB + kb0 + hstep + kstep, voffB); PG8_STAGEX(1, cX + kx0 + kstep);
        if constexpr (Epi::PREHOOK) E.prehook(S, cur);
        if (wr == 1) PG8_BAR;
        if constexpr (XR) PG8_WAIT_V(9); else PG8_WAIT_V(8);
        PG8_BAR;
        if constexpr (XR) PG8_WAIT_V(7); else PG8_WAIT_V(6);
        PG8_BAR;
    } else {
        PG8_STAGE(PG8_SB(0, 0), cB + kb0, voffB); PG8_STAGE(PG8_SA(0, 0), cA + ka0, voffA); PG8_STAGE(PG8_SB(0, 1), cB + kb0 + hstep, voffB); PG8_STAGE(PG8_SA(0, 1), cA + ka0 + hstepA, voffA);
        if (wr == 1) PG8_BAR;
        PG8_WAIT_V(4); PG8_BAR;
        PG8_STAGE(PG8_SB(1, 0), cB + kb0 + kstep, voffB); PG8_STAGE(PG8_SA(1, 0), cA + ka0 + kstep, voffA); PG8_STAGE(PG8_SB(1, 1), cB + kb0 + hstep + kstep, voffB);
        PG8_WAIT_V(6); PG8_BAR;
    }
    for (;;) {
        const bool has_next = S.next(ui + 1, nxt);
        const char* nA = has_next ? (const char*)g.A + (size_t)nxt.pm * tstep : cA; const char* nB = has_next ? (const char*)g.Bt + (size_t)nxt.pn * tstep : cB;
        const char* nX = (XR && has_next) ? (const char*)g.Ax + (size_t)(nxt.pm >> 1) * xstep : cX;
        for (int t = 0; t < nt; t += 2) {
            if constexpr (Epi::MIDSCALE) { if (t == (nt >> 1)) E.midscale(acc, cur, wr, fr); }
            const bool last = (t == nt - 2);
            const char* a1 = cA + PG8_KOA(t) + kstep;
            const char* a2 = last ? nA + ka0 : cA + PG8_KOA(t + 2); const char* b2 = last ? nB + kb0 : cB + PG8_KOB(t + 2);
            const char* x2 = XR ? (last ? nX + kx0 : cX + PG8_KOX(t + 2)) : nullptr; const char* x3 = XR ? x2 + kstep : nullptr;
            const char* a3 = a2 + kstep; const char* b3 = b2 + kstep;
            if (last && has_next) S.a_ready(nxt);
            if constexpr (SP2) {
            PG8_LDB(B0, 0, 0); PG8_LDB(B1, 0, 1); PG8_SCHED; PG8_LDA(At, 0, 0); PG8_LDX(0); PG8_STAGE(PG8_SA(1, 1), a1 + hstepA, voffA);
            PG8_WAIT_LOOP(); PG8_WAIT_L(0); PG8_BAR; PG8_MMA(0, 0, At, B0); PG8_MMA(0, 1, At, B1); PG8_MMAX(); PG8_BAR; PG8_SCHED;
            PG8_LDA(At, 0, 1); PG8_STAGE(PG8_SB(0, 0), b2, voffB); PG8_STAGE(PG8_SB(0, 1), b2 + hstep, voffB); PG8_STAGE(PG8_SA(0, 0), a2, voffA); PG8_STAGEX(0, x2);
            PG8_WAIT_LOOP(); PG8_WAIT_L(0); PG8_BAR; PG8_MMA(1, 0, At, B0); PG8_MMA(1, 1, At, B1); PG8_BAR; PG8_SCHED;
            PG8_LDB(B0, 1, 0); PG8_LDB(B1, 1, 1); PG8_SCHED; PG8_LDA(At, 1, 0); PG8_LDX(1); PG8_STAGE(PG8_SA(0, 1), a2 + hstepA, voffA);
            PG8_WAIT_LOOP(); PG8_WAIT_L(0); PG8_BAR; PG8_MMA(0, 0, At, B0); PG8_MMA(0, 1, At, B1); PG8_MMAX(); PG8_BAR; PG8_SCHED;
            PG8_LDA(At, 1, 1); PG8_STAGE(PG8_SB(1, 0), b3, voffB); PG8_STAGE(PG8_SB(1, 1), b3 + hstep, voffB); PG8_STAGE(PG8_SA(1, 0), a3, voffA); PG8_STAGEX(1, x3);
            PG8_WAIT_LOOP(); PG8_WAIT_L(0); PG8_BAR; PG8_MMA(1, 0, At, B0); PG8_MMA(1, 1, At, B1); PG8_BAR; PG8_SCHED;
            } else {
            PG8_LDB(B0, 0, 0); PG8_SCHED; PG8_LDA(At, 0, 0); PG8_STAGE(PG8_SA(1, 1), a1 + hstepA, voffA);
            PG8_WAIT_L(8); PG8_BAR; PG8_WAIT_L(0); PG8_MMA(0, 0, At, B0); PG8_BAR; PG8_SCHED;
            PG8_LDB(B1, 0, 1); PG8_STAGE(PG8_SB(0, 0), b2, voffB);
            PG8_BAR; PG8_WAIT_L(0); PG8_MMA(0, 1, At, B1); PG8_BAR;
            PG8_LDA(At, 0, 1); PG8_STAGE(PG8_SA(0, 0), a2, voffA);
            PG8_BAR; PG8_WAIT_L(0); PG8_MMA(1, 0, At, B0); PG8_BAR; PG8_SCHED;
            PG8_STAGE(PG8_SB(0, 1), b2 + hstep, voffB);
            PG8_WAIT_V(6); PG8_BAR; PG8_MMA(1, 1, At, B1); PG8_BAR;
            PG8_LDB(B0, 1, 0); PG8_SCHED; PG8_LDA(At, 1, 0); PG8_STAGE(PG8_SA(0, 1), a2 + hstepA, voffA);
            PG8_WAIT_L(8); PG8_BAR; PG8_WAIT_L(0); PG8_MMA(0, 0, At, B0); PG8_BAR; PG8_SCHED;
            PG8_LDB(B1, 1, 1); PG8_STAGE(PG8_SB(1, 0), b3, voffB);
            PG8_BAR; PG8_WAIT_L(0); PG8_MMA(0, 1, At, B1); PG8_BAR;
            PG8_LDA(At, 1, 1); PG8_STAGE(PG8_SA(1, 0), a3, voffA);
            PG8_BAR; PG8_WAIT_L(0); PG8_MMA(1, 0, At, B0); PG8_BAR; PG8_SCHED;
            PG8_STAGE(PG8_SB(1, 1), b3 + hstep, voffB);
            PG8_WAIT_V(6); PG8_BAR; PG8_MMA(1, 1, At, B1); PG8_BAR;
            }
        }
        if constexpr (ALIGN_EPI) { if (wr == 0) PG8_BAR; }
        if constexpr (!Epi::AFTER_DRAIN) { E(acc, cur, wr, wc, fr, fq); if constexpr (XR) { if (hasx) E.xrows(accx, cur, wr, wc, fr, fq); } S.done(cur); }
        if (!has_next) break;
#pragma unroll
        for (int a = 0; a < 2; ++a)
#pragma unroll
            for (int b = 0; b < 2; ++b)
#pragma unroll
                for (int m = 0; m < 4; ++m)
#pragma unroll
                    for (int n = 0; n < 2; ++n) acc[a][b][m][n] = (f32x4){0.f, 0.f, 0.f, 0.f};
        cur = nxt; cA = nA; cB = nB; ++ui;
        if constexpr (XR) { cX = nX; hasx = (((cur.pm & 1) == 0) == (cur.pn < xnh)); accx[0] = (f32x4){0.f, 0.f, 0.f, 0.f}; accx[1] = (f32x4){0.f, 0.f, 0.f, 0.f}; }
        if constexpr (ALIGN_EPI) { if (wr == 1) PG8_BAR; }
    }
    if constexpr (DRAIN) PG8_WAIT_V(0);
    if constexpr (!ALIGN_EPI) { if (wr == 0) PG8_BAR; }
    if constexpr (DRAIN) PG8_BAR;
    if constexpr (Epi::AFTER_DRAIN) { E.fused(acc, cur, wr, wc, fr, fq, lds, wid, lane); S.done(cur); }
#undef PG8_KOA
#undef PG8_KOX
#undef PG8_STAGEX
#undef PG8_LDX
#undef PG8_MMAX_
#undef PG8_MMAX
#undef PG8_WAIT_LOOP
#undef PG8_KOB
#undef PG8_SA
#undef PG8_SB
#undef PG8_STAGE
#undef PG8_LDA
#undef PG8_LDB
#undef PG8_MMA
#undef PG8_WAIT_V
#undef PG8_WAIT_L
#undef PG8_BAR
#undef PG8_SCHED
}
}

#ifndef PHMASK
#define PHMASK 0x1ff
#endif
#define PHON(k) (((PHMASK) >> (k)) & 1)
#ifndef PG8_SP2
#define PG8_SP2 true
#endif
#ifndef PG8_ALIGN
#define PG8_ALIGN true
#endif

constexpr int NWAVES = 8;
constexpr int NPH = 16;
#ifndef MK_N_LAUNCHES
#define MK_N_LAUNCHES 1
#endif
constexpr int N_LAUNCHES = MK_N_LAUNCHES;

constexpr int DM = 1024, NBATCH = 8, SEQ = 2048, DEPTH = 2, DECB = 128, DECS = 4;
constexpr int MP = NBATCH * SEQ, MS = DECB * DECS, M = MP + MS;
constexpr int SSMW = 512, GMW = 512, NG = 32, GC = 16, NP = 64, CHUNK = 128, NH = 4, HDIM = 128, PLE = 256, FF = 4096, INW = 1536;
enum In { I_XP = 0, I_XS, I_STRE, I_STIM, I_PP, I_PS, I_GMIX, I_WIN, I_LRE, I_LIM, I_LDT, I_BRE, I_BIM, I_CRE, I_CIM, I_DSK, I_WGLU, I_BGLU, I_GV, I_BV, I_WS, I_BS,
          I_GOS, I_GOG, I_WOUT, I_GFFN, I_WUP, I_WDN, I_GPLE, I_WPG, I_WPLE, I_GFIN, N_IN };
constexpr size_t O_Y = 0, O_REP = (size_t)M * DM, O_IMP = O_REP + 32768, O_RES = O_IMP + 32768, O_IMS = O_RES + 524288, O_VS = O_IMS + 524288, O_END = O_VS + 524288;

constexpr size_t MiB = 1u << 20, KiB = 1u << 10;
constexpr size_t WS_CTL = 0, CTL_ZERO_BYTES = 1 * MiB;
constexpr size_t WS_W = 1 * MiB, W_LAYER = 24 * MiB;
constexpr size_t WO_IN = 0, WO_GLU = 3 * MiB, WO_OUT = 3 * MiB + 512 * KiB, WO_UP = 5 * MiB + 512 * KiB, WO_DN = 13 * MiB + 512 * KiB, WO_PG = 21 * MiB + 512 * KiB, WO_PLE = 23 * MiB + 512 * KiB;
constexpr size_t WS_HB = 49 * MiB;
constexpr size_t WS_PL = 82 * MiB;
constexpr size_t WS_SSQ0 = 115 * MiB, WS_SSQ1 = WS_SSQ0 + 1088 * KiB;
constexpr size_t WS_VST = WS_SSQ1 + 1088 * KiB;
constexpr size_t WS_GS = WS_VST + 1088 * KiB;
constexpr size_t WS_TB = WS_GS + 512 * KiB;
constexpr size_t WS_WSM = WS_TB + 576 * KiB;
constexpr size_t WS_LPOW = WS_WSM + 256 * KiB;
constexpr size_t WS_GQ = WS_LPOW + 1088 * KiB;
constexpr size_t WS_WSUM = WS_GQ + 128 * KiB;
constexpr size_t WS_OVL = 122 * MiB;
constexpr size_t OV_US = 0, OV_UG = 16 * MiB + 512 * KiB, OV_VG = 33 * MiB, OV_YS = 49 * MiB + 512 * KiB, OV_YCAT = 66 * MiB, OV_PB = 99 * MiB;
constexpr size_t OV_FT = 108 * MiB, OV_WT = 109 * MiB, OV_GT = 113 * MiB;
constexpr size_t WS_END = WS_OVL + 132 * MiB;
static_assert(WS_WSUM + 4 * KiB <= WS_OVL && OV_GT + 4 * MiB <= 132 * MiB && WS_END <= 256 * MiB && OV_PB + (size_t)M * PLE * 2 <= 132 * MiB && (size_t)M * FF * 2 <= 132 * MiB, "d_ws map");
constexpr int S5T = 32, S5NC = SEQ / S5T;
constexpr int TB_LAYER = 4096 + 2 * 32768;
constexpr int CW_BAR = 4096;

constexpr int RING_BYTES = 131072, LDSCTL_OFF = RING_BYTES, MISC_OFF = LDSCTL_OFF + 320, RT_OFF = LDSCTL_OFF + 1024, LDS_BYTES = 147456;
static_assert(RT_OFF + 8192 <= LDS_BYTES, "LDS map");
static_assert(pg8::XR_OFF == RT_OFF + 8192 && pg8::XR_OFF + 4096 <= LDS_BYTES && pg8::STAGE_BYTES == RING_BYTES, "LDS map: extra-row strip slots");

#define GAS __attribute__((address_space(1)))
#define LAS __attribute__((address_space(3)))
typedef unsigned short bf16;
typedef unsigned v4u __attribute__((ext_vector_type(4)));
typedef unsigned v2u __attribute__((ext_vector_type(2)));
typedef float f32x4 __attribute__((ext_vector_type(4)));
typedef float f32x2 __attribute__((ext_vector_type(2)));
typedef short bf16x8 __attribute__((ext_vector_type(8)));
typedef GAS unsigned gu32;
#define RLX_AGENT __ATOMIC_RELAXED, __HIP_MEMORY_SCOPE_AGENT
#define LDS_WAIT() asm volatile("s_waitcnt lgkmcnt(0)" ::: "memory")
#define VM_WAIT() asm volatile("s_waitcnt vmcnt(0)" ::: "memory")
__device__ __forceinline__ unsigned f2bf(float f) { unsigned u = __builtin_bit_cast(unsigned, f); return (u + 0x7fffu + ((u >> 16) & 1u)) >> 16; }
__device__ __forceinline__ unsigned pk2(float lo, float hi) { unsigned r; asm("v_cvt_pk_bf16_f32 %0, %1, %2" : "=v"(r) : "v"(lo), "v"(hi)); return r; }
__device__ __forceinline__ float bflo(unsigned w) { return __uint_as_float(w << 16); }
__device__ __forceinline__ float bfhi(unsigned w) { return __uint_as_float(w & 0xffff0000u); }
__device__ __forceinline__ float bf1(bf16 h) { return __uint_as_float((unsigned)h << 16); }
using pg8::sigmoid_f; using pg8::gelu_tanh; using pg8::rinv16; using pg8::NORM_EPS;

#define XB_TMO      128
#define XB_XCNT(j)  (256  + 64 * (j))
#define XB_XSUB(j)  (1280 + 64 * (j))
#define XB_XGEN(j)  (2304 + 64 * (j))
#define XB_TOP      3328
#define XB_TOPGEN   3392
#define XCD_BAR_WORDS 3456
#define XB_SPIN_CAP (1u << 18)

__device__ __forceinline__ unsigned xb_ld(unsigned* p)              { return __hip_atomic_load(p, __ATOMIC_RELAXED, __HIP_MEMORY_SCOPE_AGENT); }
__device__ __forceinline__ unsigned xb_add(unsigned* p, unsigned v) { return __hip_atomic_fetch_add(p, v, __ATOMIC_RELAXED, __HIP_MEMORY_SCOPE_AGENT); }
__device__ __forceinline__ unsigned xb_xcc_id() { return (unsigned)__builtin_amdgcn_s_getreg((3 << 11) | 20) & 0xFu; }
#define XB_SPIN(cond, bar) do { unsigned _sp = 0; while (cond) { __builtin_amdgcn_s_sleep(1); \
    if ((++_sp & 255u) == 0u) { if (xb_ld(&(bar)[XB_TMO])) break; if (_sp > XB_SPIN_CAP) { atomicAdd(&(bar)[XB_TMO], 1u); break; } } } } while (0)

struct XcdBarrier {
    unsigned* bar; unsigned x;
    volatile LAS unsigned* st;
};

__device__ __forceinline__ XcdBarrier xcd_barrier_post(unsigned* bar, volatile LAS unsigned* st) {
    XcdBarrier b; b.bar = bar; b.x = xb_xcc_id(); b.st = st;
    if (threadIdx.x == 0) (void)xb_add(&bar[XB_XCNT(b.x)], 1u);
    return b;
}
__device__ __forceinline__ void xcd_barrier_complete(unsigned* bar, unsigned x, unsigned& nloc, unsigned& nx) {
    const unsigned G = gridDim.x * gridDim.y * gridDim.z;
    unsigned sum, cnt, mine, sp = 0u;
    for (;;) {
        sum = 0u; cnt = 0u; mine = 0u;
#pragma unroll
        for (unsigned j = 0; j < 16; ++j) { const unsigned c = xb_ld(&bar[XB_XCNT(j)]); sum += c; cnt += (c > 0u) ? 1u : 0u; mine = (j == x) ? c : mine; }
        if (sum == G) break;
        __builtin_amdgcn_s_sleep(1);
        if ((++sp & 255u) == 0u) { if (xb_ld(&bar[XB_TMO])) break; if (sp > XB_SPIN_CAP) { atomicAdd(&bar[XB_TMO], 1u); break; } }
    }
    nloc = mine > 0u ? mine : 1u; nx = cnt > 0u ? cnt : 1u;
}

__device__ __forceinline__ void xcd_barrier(const XcdBarrier& b) {
    asm volatile("s_waitcnt vmcnt(0)" ::: "memory");
    __syncthreads();
    if (threadIdx.x == 0) {
        unsigned* bar = b.bar;
        __builtin_amdgcn_s_waitcnt(0);
        unsigned nloc = b.st[0], nx = b.st[1];
        if (nloc == 0u) { xcd_barrier_complete(bar, b.x, nloc, nx); b.st[0] = nloc; b.st[1] = nx; }
        const unsigned old = xb_add(&bar[XB_XSUB(b.x)], 1u);
        const unsigned gen = old / nloc;
        if (old + 1u == (gen + 1u) * nloc) {
            __builtin_amdgcn_fence(__ATOMIC_RELEASE, "agent");
            asm volatile("s_waitcnt vmcnt(0)" ::: "memory");
            const unsigned og = xb_add(&bar[XB_TOP], 1u);
            const unsigned tg = og / nx;
            if (og + 1u == (tg + 1u) * nx) xb_add(&bar[XB_TOPGEN], 1u);
            else XB_SPIN(xb_ld(&bar[XB_TOPGEN]) == tg, bar);
            __builtin_amdgcn_fence(__ATOMIC_ACQUIRE, "agent");
            xb_add(&bar[XB_XGEN(b.x)], 1u);
            asm volatile("s_waitcnt vmcnt(0)" ::: "memory");
        } else {
            XB_SPIN(xb_ld(&bar[XB_XGEN(b.x)]) == gen, bar);
            __builtin_amdgcn_fence(__ATOMIC_ACQUIRE, "agent");
            asm volatile("s_waitcnt vmcnt(0)" ::: "memory");
        }
    }
    __syncthreads();
}


__device__ __forceinline__ int opq(int x) { asm volatile("" : "+s"(x)); return x; }
__device__ __forceinline__ float wave_sum(float v) {
#pragma unroll
    for (int o = 1; o < 64; o <<= 1) v += __shfl_xor(v, o);
    return v;
}
__device__ __forceinline__ void dsincos(double x, double& s, double& c) {
    const double k = __builtin_rint(x * 0.63661977236758134308);
    double r = __builtin_fma(-k, 1.57079632679489655800e+00, x);
    r = __builtin_fma(-k, 6.12323399573676603587e-17, r);
    const int q = (int)k & 3;
    const double z = r * r;
    double sp = -1.0 / 1307674368000.0; sp = sp * z + 1.0 / 6227020800.0; sp = sp * z - 1.0 / 39916800.0; sp = sp * z + 1.0 / 362880.0; sp = sp * z - 1.0 / 5040.0; sp = sp * z + 1.0 / 120.0; sp = sp * z - 1.0 / 6.0; sp = sp * z + 1.0; sp = sp * r;
    double cp = -1.0 / 87178291200.0; cp = cp * z + 1.0 / 479001600.0; cp = cp * z - 1.0 / 3628800.0; cp = cp * z + 1.0 / 40320.0; cp = cp * z - 1.0 / 720.0; cp = cp * z + 1.0 / 24.0; cp = cp * z - 0.5; cp = cp * z + 1.0;
    s = (q == 0) ? sp : (q == 1) ? cp : (q == 2) ? -sp : -cp;
    c = (q == 0) ? cp : (q == 1) ? -sp : (q == 2) ? -cp : sp;
}
__device__ __forceinline__ double dexp(double x) {
    const double k = __builtin_rint(x * 1.44269504088896338700e+00);
    double r = __builtin_fma(-k, 6.93147180369123816490e-01, x);
    r = __builtin_fma(-k, 1.90821492927058770002e-10, r);
    double p = 1.0 / 6227020800.0;
    p = p * r + 1.0 / 479001600.0; p = p * r + 1.0 / 39916800.0; p = p * r + 1.0 / 3628800.0; p = p * r + 1.0 / 362880.0; p = p * r + 1.0 / 40320.0; p = p * r + 1.0 / 5040.0;
    p = p * r + 1.0 / 720.0; p = p * r + 1.0 / 120.0; p = p * r + 1.0 / 24.0; p = p * r + 1.0 / 6.0; p = p * r + 0.5; p = p * r + 1.0; p = p * r + 1.0;
    const long long bits = ((long long)((int)k + 1023)) << 52;
    return p * __builtin_bit_cast(double, bits);
}

struct TItem { const float* W; bf16* WT; const float* gs; int K, N, k0, n0; };
__device__ __forceinline__ void p0_t_load(const TItem& t, int lane, f32x4 (&v)[8]) {
#pragma unroll
    for (int i = 0; i < 8; ++i) v[i] = *(const f32x4*)(t.W + (size_t)(t.k0 + 8 * i + (lane >> 3)) * t.N + t.n0 + 4 * (lane & 7));
}
__device__ __forceinline__ void p0_t_finish(const TItem& t, int lane, const f32x4 (&v)[8], LAS float* scr) {
#pragma unroll
    for (int i = 0; i < 8; ++i) { const int kk = 8 * i + (lane >> 3); f32x4 x = v[i]; if (t.gs) x = x * t.gs[t.k0 + kk]; LAS float* d = scr + kk * 33 + 4 * (lane & 7); d[0] = x[0]; d[1] = x[1]; d[2] = x[2]; d[3] = x[3]; }
    LDS_WAIT(); asm volatile("" ::: "memory");
    const int c = lane & 7;
#pragma unroll
    for (int j = 0; j < 4; ++j) { const int n = (lane >> 3) + 8 * j; const LAS float* s = scr + (8 * c) * 33 + n;
        v4u o; o.x = pk2(s[0 * 33], s[1 * 33]); o.y = pk2(s[2 * 33], s[3 * 33]); o.z = pk2(s[4 * 33], s[5 * 33]); o.w = pk2(s[6 * 33], s[7 * 33]);
        *(GAS v4u*)(t.WT + (size_t)(t.n0 + n) * t.K + t.k0 + 8 * c) = o; }
    LDS_WAIT(); asm volatile("" ::: "memory");
}
struct Args { const float* in[N_IN]; float* out; unsigned char* ws; int ph_lo, ph_hi, li, pad; };

constexpr int P0_I_IN = 16 * 48, P0_I_GLU = 8 * 16, P0_I_OUT = 16 * 32, P0_I_UP = 16 * 128, P0_I_DN = 64 * 32, P0_I_PG = 16 * 32, P0_I_PLE = 4 * 32, P0_I_LAYER = P0_I_IN + P0_I_GLU + P0_I_OUT + P0_I_UP + P0_I_DN + P0_I_PG + P0_I_PLE;
__device__ __forceinline__ void p0_convert(const Args& args, LAS unsigned char* lds, int lane, int wave, int gw, int NGW, int it_lo, int it_hi) {
    unsigned char* ws = args.ws;
    LAS float* scr = (LAS float*)(lds + wave * 16384);
    constexpr int I_IN = P0_I_IN, I_GLU = P0_I_GLU, I_OUT = P0_I_OUT, I_UP = P0_I_UP, I_DN = P0_I_DN, I_PG = P0_I_PG, I_LAYER = P0_I_LAYER;
    auto item = [&](int it, TItem& t) {
        const int L = it / I_LAYER; int r = it % I_LAYER; unsigned char* wl = ws + WS_W + (size_t)L * W_LAYER; int nblk;
        if (r < I_IN) { t.W = args.in[I_WIN] + (size_t)L * DM * INW; t.K = DM; t.N = INW; t.WT = (bf16*)(wl + WO_IN); t.gs = args.in[I_GMIX] + L * DM; }
        else if ((r -= I_IN) < I_GLU) { t.W = args.in[I_WGLU] + (size_t)L * SSMW * SSMW; t.K = SSMW; t.N = SSMW; t.WT = (bf16*)(wl + WO_GLU); t.gs = nullptr; }
        else if ((r -= I_GLU) < I_OUT) { t.W = args.in[I_WOUT] + (size_t)L * DM * DM; t.K = DM; t.N = DM; t.WT = (bf16*)(wl + WO_OUT); t.gs = (r / 32 < 8) ? args.in[I_GOS] + L * SSMW : args.in[I_GOG] + L * GMW - SSMW; }
        else if ((r -= I_OUT) < I_UP) { t.W = args.in[I_WUP] + (size_t)L * DM * FF; t.K = DM; t.N = FF; t.WT = (bf16*)(wl + WO_UP); t.gs = args.in[I_GFFN] + L * DM; }
        else if ((r -= I_UP) < I_DN) { t.W = args.in[I_WDN] + (size_t)L * FF * DM; t.K = FF; t.N = DM; t.WT = (bf16*)(wl + WO_DN); t.gs = nullptr; }
        else if ((r -= I_DN) < I_PG) { t.W = args.in[I_WPG] + (size_t)L * DM * DM; t.K = DM; t.N = DM; t.WT = (bf16*)(wl + WO_PG); t.gs = args.in[I_GPLE] + L * DM; }
        else { r -= I_PG; t.W = args.in[I_WPLE] + (size_t)L * PLE * DM; t.K = PLE; t.N = DM; t.WT = (bf16*)(wl + WO_PLE); t.gs = nullptr; }
        nblk = t.N / 32; t.k0 = 64 * (r / nblk); t.n0 = 32 * (r % nblk);
    };
    for (int it = it_lo + gw; it < it_hi; it += 2 * NGW) {
        TItem ta, tb2; f32x4 va[8], vb[8]; const bool two = it + NGW < it_hi;
        item(it, ta); p0_t_load(ta, lane, va);
        if (two) { item(it + NGW, tb2); p0_t_load(tb2, lane, vb); }
        p0_t_finish(ta, lane, va, scr);
        if (two) p0_t_finish(tb2, lane, vb, scr);
    }
}
__device__ __forceinline__ void p0_prologue(const Args& args, LAS unsigned char* lds, int tid, int lane, int wave, int bx, int G) {
    unsigned char* ws = args.ws;
    const int gw = bx * NWAVES + wave, NGW = G * NWAVES;
    const int gt = bx * (NWAVES * 64) + tid, NGT = G * NWAVES * 64;
    p0_convert(args, lds, lane, wave, gw, NGW, 0, P0_I_IN);
    {
        bf16* hb = (bf16*)(ws + WS_HB); float* ssq = (float*)(ws + WS_SSQ0);
        for (int m0 = gw; m0 < M; m0 += 3 * NGW) {
            f32x4 v[3][4];
#pragma unroll
            for (int q = 0; q < 3; ++q) { const int m = m0 + q * NGW; if (m < M) { const float* src = (m < MP) ? args.in[I_XP] + (size_t)m * DM : args.in[I_XS] + (size_t)(m - MP) * DM;
                const GAS f32x4* xr = (const GAS f32x4*)src + 2 * lane;
#pragma unroll
                for (int j = 0; j < 2; ++j) { v[q][2 * j] = xr[128 * j]; v[q][2 * j + 1] = xr[128 * j + 1]; } } }
#pragma unroll
            for (int q = 0; q < 3; ++q) { const int m = m0 + q * NGW; if (m < M) { GAS v4u* br = (GAS v4u*)(hb + (size_t)m * DM) + lane; float s = 0.f;
#pragma unroll
                for (int j = 0; j < 2; ++j) { const f32x4 x = v[q][2 * j], y = v[q][2 * j + 1]; v4u o; o.x = pk2(x[0], x[1]); o.y = pk2(x[2], x[3]); o.z = pk2(y[0], y[1]); o.w = pk2(y[2], y[3]); br[64 * j] = o;
                    s += ((x[0] * x[0] + x[1] * x[1]) + (x[2] * x[2] + x[3] * x[3])) + ((y[0] * y[0] + y[1] * y[1]) + (y[2] * y[2] + y[3] * y[3])); }
                s = wave_sum(s);
                if (lane < 16) ssq[(size_t)m * 16 + lane] = (lane == 0) ? s : 0.f; } }
        }
    }
    if (gt < DEPTH * NG * NP) {
        const int L = gt >> 11, gp = gt & 2047, g = gp >> 6;
        float* tb = (float*)(ws + WS_TB) + (size_t)L * TB_LAYER;
        double lr = (double)args.in[I_LRE][L * 2048 + gp]; lr = lr < -1e-4 ? lr : -1e-4;
        const double li = (double)args.in[I_LIM][L * 2048 + gp];
        const double dt = dexp((double)args.in[I_LDT][L * NG + g]);
        const double mag = dexp(lr * dt); double sn, cs; dsincos(li * dt, sn, cs);
        const double abr = mag * cs, abi = mag * sn, den = lr * lr + li * li, nr = abr - 1.0, ni = abi;
        const double qr = (nr * lr + ni * li) / den, qi = (ni * lr - nr * li) / den;
        tb[gp] = (float)abr; tb[2048 + gp] = (float)abi;
        const float* bre = args.in[I_BRE] + ((size_t)L * 2048 + gp) * GC; const float* bim = args.in[I_BIM] + ((size_t)L * 2048 + gp) * GC;
#pragma unroll
        for (int h = 0; h < GC; ++h) { const double br = (double)bre[h], bi = (double)bim[h];
            tb[4096 + gp * GC + h] = (float)(qr * br - qi * bi); tb[4096 + 32768 + gp * GC + h] = (float)(qr * bi + qi * br); }
    }
    for (int e = gt; e < DEPTH * NG * NP * (S5T + 1); e += NGT) {
        const int d = e % (S5T + 1), lgp = e / (S5T + 1), p = lgp & 63, lg = lgp >> 6;
        double lr = (double)args.in[I_LRE][lgp]; lr = lr < -1e-4 ? lr : -1e-4; const double li = (double)args.in[I_LIM][lgp];
        const double dt = dexp((double)args.in[I_LDT][lg]);
        const double md = dexp(lr * dt * (double)d); double sd, cd; dsincos(li * dt * (double)d, sd, cd);
        float* lp = (float*)(ws + WS_LPOW) + (((size_t)lg * (S5T + 1) + d) * NP + p) * 2; lp[0] = (float)(md * cd); lp[1] = (float)(md * sd);
    }
    {
        bf16* wsm = (bf16*)(ws + WS_WSM); const float* w_s = args.in[I_WS];
        for (int e = gt; e < DEPTH * NH * CHUNK * CHUNK; e += NGT) { const int s = e & 127, t = (e >> 7) & 127; wsm[e] = (s <= t) ? (bf16)f2bf(w_s[e]) : (bf16)0; }
        float* wsum = (float*)(ws + WS_WSUM);
        for (int e = gw; e < DEPTH * NH * CHUNK; e += NGW) { const int t = e & 127;
            const float a0 = (lane <= t) ? bf1((bf16)f2bf(w_s[(size_t)e * CHUNK + lane])) : 0.f, a1 = (lane + 64 <= t) ? bf1((bf16)f2bf(w_s[(size_t)e * CHUNK + 64 + lane])) : 0.f;
            const float a = wave_sum(a0 + a1); if (lane == 0) wsum[e] = a; }
    }
}

__device__ __forceinline__ void s5_sample_wave(int lane, int b, int g, const float* tb, const float* cre, const float* cim, const float* dsk,
                                               const bf16* US, bf16* YS, const float* st_re, const float* st_im, float* out_re, float* out_im) {
    const int p = lane, gp = g * 64 + p;
    const float ar = tb[gp], ai = tb[2048 + gp];
    float bbr[16], bbi[16], cr[16], ci[16];
#pragma unroll
    for (int q = 0; q < 4; ++q) { const f32x4 a = *(const f32x4*)(tb + 4096 + gp * 16 + 4 * q), c = *(const f32x4*)(tb + 4096 + 32768 + gp * 16 + 4 * q);
#pragma unroll
        for (int j = 0; j < 4; ++j) { bbr[4 * q + j] = a[j]; bbi[4 * q + j] = c[j]; } }
#pragma unroll
    for (int h = 0; h < 16; ++h) { cr[h] = cre[(size_t)(g * 16 + h) * 64 + p]; ci[h] = cim[(size_t)(g * 16 + h) * 64 + p]; }
    float hr = st_re[(size_t)(b * NG + g) * NP + p], hi = st_im[(size_t)(b * NG + g) * NP + p];
    const int ho = ((lane >> 5) & 1) * 8 + ((lane >> 4) & 1) * 4 + ((lane >> 3) & 1) * 2 + ((lane >> 2) & 1);
    const bf16* up0 = US + ((size_t)g * M + MP + (size_t)b * DECS) * 16;
    v4u qa[DECS], qb[DECS]; float uho[DECS];
#pragma unroll
    for (int j = 0; j < DECS; ++j) { qa[j] = *(const v4u*)(up0 + 16 * j); qb[j] = *(const v4u*)(up0 + 16 * j + 8); uho[j] = bf1(up0[16 * j + ho]); }
    const float dkh = dsk[g * 16 + ho];
#pragma unroll
    for (int j = 0; j < DECS; ++j) {
        const size_t row = (size_t)MP + b * DECS + j;
        const v4u q0 = qa[j], q1 = qb[j];
        float u[16];
        u[0] = bflo(q0.x); u[1] = bfhi(q0.x); u[2] = bflo(q0.y); u[3] = bfhi(q0.y); u[4] = bflo(q0.z); u[5] = bfhi(q0.z); u[6] = bflo(q0.w); u[7] = bfhi(q0.w);
        u[8] = bflo(q1.x); u[9] = bfhi(q1.x); u[10] = bflo(q1.y); u[11] = bfhi(q1.y); u[12] = bflo(q1.z); u[13] = bfhi(q1.z); u[14] = bflo(q1.w); u[15] = bfhi(q1.w);
        float br = 0.f, bi = 0.f;
#pragma unroll
        for (int h = 0; h < 16; ++h) { br += bbr[h] * u[h]; bi += bbi[h] * u[h]; }
        const float nr = ar * hr - ai * hi + br, ni = ar * hi + ai * hr + bi; hr = nr; hi = ni;
        float v8[8], v4[4], v2[2], v1;
#pragma unroll
        for (int h = 0; h < 8; ++h) { const float lo = cr[h] * hr - ci[h] * hi, hi8 = cr[h + 8] * hr - ci[h + 8] * hi; const bool up5 = (lane & 32) != 0;
            const float keep = up5 ? hi8 : lo, send = up5 ? lo : hi8; v8[h] = keep + __shfl_xor(send, 32); }
#pragma unroll
        for (int h = 0; h < 4; ++h) { const bool b = (lane & 16) != 0; const float keep = b ? v8[h + 4] : v8[h], send = b ? v8[h] : v8[h + 4]; v4[h] = keep + __shfl_xor(send, 16); }
#pragma unroll
        for (int h = 0; h < 2; ++h) { const bool b = (lane & 8) != 0; const float keep = b ? v4[h + 2] : v4[h], send = b ? v4[h] : v4[h + 2]; v2[h] = keep + __shfl_xor(send, 8); }
        { const bool b = (lane & 4) != 0; const float keep = b ? v2[1] : v2[0], send = b ? v2[0] : v2[1]; v1 = keep + __shfl_xor(send, 4); }
        v1 += __shfl_xor(v1, 2); v1 += __shfl_xor(v1, 1);
        const float yv = v1 + dkh * uho[j];
        if ((lane & 3) == 0) YS[row * SSMW + g * 16 + ho] = (bf16)f2bf(gelu_tanh(yv));
    }
    out_re[(size_t)(b * NG + g) * NP + p] = hr; out_im[(size_t)(b * NG + g) * NP + p] = hi;
}

__device__ __forceinline__ void s5_build_tables(int vt, int NV, const float* tb, const float* lpow, const float* cre, const float* cim, bf16* FT, bf16* WT, bf16* GT) {
    const float* bbr = tb + 4096; const float* bbi = tb + 4096 + 32768;
    const float* abr = tb; const float* abi = tb + 2048;
    for (int e = vt; e < NG * GC * GC * 8; e += NV) {
        const int p8 = e & 7, hi = (e >> 3) & 15, ho = (e >> 7) & 15, g = e >> 11;
        float kd[S5T];
#pragma unroll
        for (int d = 0; d < S5T; ++d) kd[d] = 0.f;
        float ca[8], cb[8], ba[8], bb[8], la[8], lb[8];
#pragma unroll
        for (int q = 0; q < 8; ++q) { const int p = 8 * p8 + q; ca[q] = cre[(size_t)(g * GC + ho) * NP + p]; cb[q] = cim[(size_t)(g * GC + ho) * NP + p];
            ba[q] = bbr[(size_t)(g * NP + p) * GC + hi]; bb[q] = bbi[(size_t)(g * NP + p) * GC + hi]; la[q] = abr[g * NP + p]; lb[q] = abi[g * NP + p]; }
#pragma unroll
        for (int q = 0; q < 8; ++q) { const float lr = la[q], li = lb[q]; float zr = ca[q] * ba[q] - cb[q] * bb[q], zi = ca[q] * bb[q] + cb[q] * ba[q];
#pragma unroll
            for (int d = 0; d < S5T; ++d) { kd[d] += zr; const float nr = zr * lr - zi * li, ni = zr * li + zi * lr; zr = nr; zi = ni; } }
        bf16* fg = FT + (size_t)g * S5T * 512;
#pragma unroll
        for (int d = 0; d < S5T; ++d) { float v = kd[d]; v += __shfl_xor(v, 1); v += __shfl_xor(v, 2); v += __shfl_xor(v, 4);
            if (p8 == (d & 7)) { const bf16 w = (bf16)f2bf(v);
                fg[(size_t)d * 512 + (ho + 16 * (hi >> 3)) * 8 + (hi & 7)] = w;
                if (d + 1 < S5T) fg[(size_t)(d + 1) * 512 + (ho + 16 * (2 + (hi >> 3))) * 8 + (hi & 7)] = w;
                if (d == 0) fg[(ho + 16 * (2 + (hi >> 3))) * 8 + (hi & 7)] = (bf16)0; } }
    }
    for (int e0 = vt; e0 < NG * 8 * 16 * 64; e0 += 4 * NV) {
        f32x2 lq[4]; f32x4 br[4][2], bi[4][2];
#pragma unroll
        for (int u = 0; u < 4; ++u) { const int e = e0 + u * NV; if (e < NG * 8 * 16 * 64) { const int lane = e & 63, ks = (e >> 6) & 15, nb = (e >> 10) & 7, g = e >> 13, fr = lane & 15, fq = lane >> 4;
            const int p = (16 * nb + fr) >> 1, s = 2 * ks + (fq >> 1);
            lq[u] = *(const f32x2*)(lpow + (((size_t)g * (S5T + 1) + (S5T - 1 - s)) * NP + p) * 2);
            const f32x4* b0 = (const f32x4*)(bbr + (size_t)(g * NP + p) * GC + 8 * (fq & 1)); const f32x4* b1 = (const f32x4*)(bbi + (size_t)(g * NP + p) * GC + 8 * (fq & 1));
            br[u][0] = b0[0]; br[u][1] = b0[1]; bi[u][0] = b1[0]; bi[u][1] = b1[1]; } }
#pragma unroll
        for (int u = 0; u < 4; ++u) { const int e = e0 + u * NV; if (e < NG * 8 * 16 * 64) { const bool im = (e & 1) != 0;
            const float lr = lq[u].x, li = lq[u].y; float z[8];
#pragma unroll
            for (int j = 0; j < 8; ++j) { const float b_r = br[u][j >> 2][j & 3], b_i = bi[u][j >> 2][j & 3]; z[j] = im ? (lr * b_i + li * b_r) : (lr * b_r - li * b_i); }
            v4u o; o.x = pk2(z[0], z[1]); o.y = pk2(z[2], z[3]); o.z = pk2(z[4], z[5]); o.w = pk2(z[6], z[7]);
            *(v4u*)(WT + (size_t)e * 8) = o; } }
    }
    for (int e0 = vt; e0 < NG * S5T * 4 * 64; e0 += 4 * NV) {
        f32x4 lp[4][2], cr[4], ci[4];
#pragma unroll
        for (int u = 0; u < 4; ++u) { const int e = e0 + u * NV; if (e < NG * S5T * 4 * 64) { const int lane = e & 63, kk = (e >> 6) & 3, tau = (e >> 8) & 31, g = e >> 13, fr = lane & 15, fq = lane >> 4;
            const int p0 = 16 * kk + 4 * fq;
            const f32x4* l4 = (const f32x4*)(lpow + (((size_t)g * (S5T + 1) + (tau + 1)) * NP + p0) * 2); lp[u][0] = l4[0]; lp[u][1] = l4[1];
            cr[u] = *(const f32x4*)(cre + (size_t)(g * GC + fr) * NP + p0); ci[u] = *(const f32x4*)(cim + (size_t)(g * GC + fr) * NP + p0); } }
#pragma unroll
        for (int u = 0; u < 4; ++u) { const int e = e0 + u * NV; if (e < NG * S5T * 4 * 64) { float z[8];
#pragma unroll
            for (int q = 0; q < 4; ++q) { const float lr = lp[u][q >> 1][2 * (q & 1)], li = lp[u][q >> 1][2 * (q & 1) + 1], a = cr[u][q], b = ci[u][q]; z[2 * q] = a * lr - b * li; z[2 * q + 1] = -(a * li + b * lr); }
            v4u o; o.x = pk2(z[0], z[1]); o.y = pk2(z[2], z[3]); o.z = pk2(z[4], z[5]); o.w = pk2(z[6], z[7]);
            *(v4u*)(GT + (size_t)e * 8) = o; } }
    }
}
__device__ __forceinline__ void s5_prompt_item_mfma(LAS unsigned char* lds, int tid0, int lane0, int wave, int n, int g, const bf16* USg, const bf16* FTg, const bf16* WTg, const bf16* GTg,
                                                    const float* ltp, const float* dsk, bf16* YS, float* out_re, float* out_im) {
    constexpr int U_OFF = 0, R2_OFF = 64 * 1056, HP_OFF = R2_OFF + 64 * 132 * 4;
#define S5_LAUNDER() int tid_ = tid0, lane_ = lane0; asm volatile("" : "+v"(tid_), "+v"(lane_)); const int tid = tid_, lane = lane_, fr = lane & 15, fq = lane >> 4; (void)tid; (void)fr; (void)fq
    { S5_LAUNDER(); const bf16* usrc = USg + ((size_t)g * M + (size_t)n * SEQ) * 16;
#pragma unroll
      for (int it = 0; it < 8; ++it) { const int q = tid + 512 * it, token = q >> 1, half = q & 1; const v4u v = *(const v4u*)(usrc + (size_t)token * 16 + 8 * half);
          *(LAS v4u*)(lds + U_OFF + (token >> 5) * 1056 + (token & 31) * 32 + 16 * half) = v; } }
    bf16x8 wa[16];
    { S5_LAUNDER();
#pragma unroll
    for (int ks = 0; ks < 16; ++ks) wa[ks] = *(const bf16x8*)(WTg + ((size_t)(wave * 16 + ks) * 64 + lane) * 8);
    }
    __syncthreads();
    {   S5_LAUNDER();
        f32x4 accS[4];
#pragma unroll
        for (int cb = 0; cb < 4; ++cb) accS[cb] = (f32x4){0.f, 0.f, 0.f, 0.f};
#pragma unroll
        for (int ks = 0; ks < 16; ++ks) {
#pragma unroll
            for (int cb = 0; cb < 4; ++cb) { const bf16x8 b = *(const LAS bf16x8*)(lds + U_OFF + (16 * cb + fr) * 1056 + (2 * ks + (fq >> 1)) * 32 + 16 * (fq & 1));
                accS[cb] = __builtin_amdgcn_mfma_f32_16x16x32_bf16(wa[ks], b, accS[cb], 0, 0, 0); }
            if (ks & 1) asm volatile("" ::: "memory"); }
#pragma unroll
        for (int cb = 0; cb < 4; ++cb) *(LAS f32x4*)(lds + R2_OFF + ((16 * cb + fr) * 132 + 16 * wave + 4 * fq) * 4) = accS[cb];
    }
    __syncthreads();
    { S5_LAUNDER(); if (tid < 64) {
        const int p = tid; const float lr = ltp[2 * p], li = ltp[2 * p + 1]; float hr = 0.f, hi = 0.f;
#pragma unroll 8
        for (int c = 0; c < S5NC; ++c) { *(LAS unsigned*)(lds + HP_OFF + c * 272 + 4 * p) = pk2(hr, hi);
            const f32x2 sv = *(const LAS f32x2*)(lds + R2_OFF + (c * 132 + 2 * p) * 4);
            const float nr = lr * hr - li * hi + sv.x, ni = lr * hi + li * hr + sv.y; hr = nr; hi = ni; }
        out_re[p] = hr; out_im[p] = hi;
    } }
    __syncthreads();
    S5_LAUNDER();
#pragma unroll
    for (int it = 0; it < 4; ++it) { const int q = tid + 512 * it; *(LAS v4u*)(lds + R2_OFF + q * 16) = *(const v4u*)(FTg + (size_t)q * 8); }
    const int tau0 = wave, tau1 = 15 - wave, tau2 = 16 + wave, tau3 = 31 - wave;
    bf16x8 ga[4][4];
#pragma unroll
    for (int kk = 0; kk < 4; ++kk) { ga[0][kk] = *(const bf16x8*)(GTg + ((size_t)(tau0 * 4 + kk) * 64 + lane) * 8); ga[1][kk] = *(const bf16x8*)(GTg + ((size_t)(tau1 * 4 + kk) * 64 + lane) * 8);
                                     ga[2][kk] = *(const bf16x8*)(GTg + ((size_t)(tau2 * 4 + kk) * 64 + lane) * 8); ga[3][kk] = *(const bf16x8*)(GTg + ((size_t)(tau3 * 4 + kk) * 64 + lane) * 8); }
    const f32x4 dk = *(const f32x4*)(dsk + 4 * fq);
    __syncthreads();
#pragma unroll
    for (int j = 0; j < 4; ++j) {
        const int tau = (j == 0) ? tau0 : (j == 1) ? tau1 : (j == 2) ? tau2 : tau3;
        f32x4 acc[4];
#pragma unroll
        for (int cb = 0; cb < 4; ++cb) acc[cb] = (f32x4){0.f, 0.f, 0.f, 0.f};
#pragma unroll 1
        for (int ks = 0; ks <= (tau >> 1); ++ks) { const bf16x8 fa = *(const LAS bf16x8*)(lds + R2_OFF + ((tau - 2 * ks) * 64 + lane) * 16);
#pragma unroll
            for (int cb = 0; cb < 4; ++cb) { const bf16x8 ub = *(const LAS bf16x8*)(lds + U_OFF + (16 * cb + fr) * 1056 + (2 * ks + (fq >> 1)) * 32 + 16 * (fq & 1));
                acc[cb] = __builtin_amdgcn_mfma_f32_16x16x32_bf16(fa, ub, acc[cb], 0, 0, 0); } }
#pragma unroll
        for (int kk = 0; kk < 4; ++kk)
#pragma unroll
            for (int cb = 0; cb < 4; ++cb) { const bf16x8 hb = *(const LAS bf16x8*)(lds + HP_OFF + (16 * cb + fr) * 272 + 64 * kk + 16 * fq);
                acc[cb] = __builtin_amdgcn_mfma_f32_16x16x32_bf16(ga[j][kk], hb, acc[cb], 0, 0, 0); }
#pragma unroll
        for (int cb = 0; cb < 4; ++cb) { const int tok = (16 * cb + fr) * S5T + tau;
            const v2u uu = *(const LAS v2u*)(lds + U_OFF + (16 * cb + fr) * 1056 + tau * 32 + 8 * fq);
            const float y0 = gelu_tanh(acc[cb][0] + dk[0] * bflo(uu.x)), y1 = gelu_tanh(acc[cb][1] + dk[1] * bfhi(uu.x)), y2 = gelu_tanh(acc[cb][2] + dk[2] * bflo(uu.y)), y3 = gelu_tanh(acc[cb][3] + dk[3] * bfhi(uu.y));
            v2u o; o.x = pk2(y0, y1); o.y = pk2(y2, y3);
            *(v2u*)(YS + ((size_t)n * SEQ + tok) * SSMW + g * 16 + 4 * fq) = o; }
    }
    __syncthreads();
#undef S5_LAUNDER
}
__device__ __forceinline__ void gmlp_prompt_item(LAS unsigned char* lds, int tid, int lane, int wave, size_t row0, const bf16* VG, const bf16* UG, const float* VST,
                                                 const bf16* wsm, const float* wsums, const float* g_v, const float* b_v, const float* b_s, bf16* YCAT, float* GQ, int h0) {
    LAS bf16* vT = (LAS bf16*)lds;
    LAS float* mu = (LAS float*)(lds + 128 * 136 * 2);
    LAS float* rs = mu + 128;
    LAS float* red = rs + 128;
    const int fr = lane & 15, fq = lane >> 4;
    if (tid < 128) { const f32x4* q = (const f32x4*)(VST + (row0 + tid) * 16); const f32x4 a = q[0], b = q[1], c = q[2], d = q[3];
        const float s1 = (a[0] + a[2]) + (b[0] + b[2]) + (c[0] + c[2]) + (d[0] + d[2]), s2 = (a[1] + a[3]) + (b[1] + b[3]) + (c[1] + c[3]) + (d[1] + d[3]);
        const float m = s1 * (1.0f / 512.0f); float var = s2 * (1.0f / 512.0f) - m * m; var = var > 0.f ? var : 0.f;
        mu[tid] = m; rs[tid] = __builtin_amdgcn_rsqf(var + NORM_EPS); }
    __syncthreads();
    float sq[8];
#pragma unroll
    for (int i = 0; i < 8; ++i) sq[i] = 0.f;
    v4u vq[4]; v2u uqn[8]; float biasn[8];
#pragma unroll
    for (int it = 0; it < 4; ++it) { const int piece = tid + 512 * it; vq[it] = *(const v4u*)(VG + (row0 + (piece & 127)) * GMW + h0 * 128 + 8 * (piece >> 7)); }
#pragma unroll
    for (int tb = 0; tb < 8; ++tb) { uqn[tb] = *(const v2u*)(UG + (row0 + 16 * tb + fr) * GMW + h0 * 128 + 16 * wave + 4 * fq); biasn[tb] = b_s[h0 * 128 + 16 * tb + fr]; }
#pragma unroll 1
    for (int h = h0; h < h0 + 2; ++h) {
#pragma unroll
        for (int it = 0; it < 4; ++it) { const int piece = tid + 512 * it, s = piece & 127, c0 = 8 * (piece >> 7);
            const v4u q = vq[it];
            const float m = mu[s], r = rs[s];
            LAS bf16* d = vT + c0 * 136 + s;
            const unsigned p0 = pk2((bflo(q.x) - m) * r, (bfhi(q.x) - m) * r), p1 = pk2((bflo(q.y) - m) * r, (bfhi(q.y) - m) * r), p2 = pk2((bflo(q.z) - m) * r, (bfhi(q.z) - m) * r), p3 = pk2((bflo(q.w) - m) * r, (bfhi(q.w) - m) * r);
            d[0 * 136] = (bf16)p0; d[1 * 136] = (bf16)(p0 >> 16); d[2 * 136] = (bf16)p1; d[3 * 136] = (bf16)(p1 >> 16);
            d[4 * 136] = (bf16)p2; d[5 * 136] = (bf16)(p2 >> 16); d[6 * 136] = (bf16)p3; d[7 * 136] = (bf16)(p3 >> 16); }
        v2u uq[8]; float bias[8];
#pragma unroll
        for (int tb = 0; tb < 8; ++tb) { uq[tb] = uqn[tb]; bias[tb] = biasn[tb]; }
        if (h == h0) {
#pragma unroll
            for (int it = 0; it < 4; ++it) { const int piece = tid + 512 * it; vq[it] = *(const v4u*)(VG + (row0 + (piece & 127)) * GMW + (h + 1) * 128 + 8 * (piece >> 7)); }
#pragma unroll
            for (int tb = 0; tb < 8; ++tb) { uqn[tb] = *(const v2u*)(UG + (row0 + 16 * tb + fr) * GMW + (h + 1) * 128 + 16 * wave + 4 * fq); biasn[tb] = b_s[(h + 1) * 128 + 16 * tb + fr]; } }
        __syncthreads();
        bf16x8 a[4];
#pragma unroll
        for (int ks = 0; ks < 4; ++ks) a[ks] = *(const LAS bf16x8*)(vT + (16 * wave + fr) * 136 + 32 * ks + 8 * fq);
        const f32x4 gc = *(const f32x4*)(g_v + h * 128 + 16 * wave + 4 * fq), bc = *(const f32x4*)(b_v + h * 128 + 16 * wave + 4 * fq);
#pragma unroll
        for (int tb = 0; tb < 8; ++tb) {
            f32x4 acc = (f32x4){0.f, 0.f, 0.f, 0.f};
#pragma unroll
            for (int ks = 0; ks <= (tb >> 1); ++ks) { const bf16x8 b = *(const bf16x8*)(wsm + (size_t)(h * 128 + 16 * tb + fr) * 128 + 32 * ks + 8 * fq);
                acc = __builtin_amdgcn_mfma_f32_16x16x32_bf16(a[ks], b, acc, 0, 0, 0); }
            const int t = 16 * tb + fr;
            const float wsum = wsums[h * 128 + t];
            f32x4 y; y[0] = bflo(uq[tb].x) * (gc[0] * acc[0] + bc[0] * wsum + bias[tb]); y[1] = bfhi(uq[tb].x) * (gc[1] * acc[1] + bc[1] * wsum + bias[tb]);
            y[2] = bflo(uq[tb].y) * (gc[2] * acc[2] + bc[2] * wsum + bias[tb]); y[3] = bfhi(uq[tb].y) * (gc[3] * acc[3] + bc[3] * wsum + bias[tb]);
            sq[tb] += (y[0] * y[0] + y[1] * y[1]) + (y[2] * y[2] + y[3] * y[3]);
            v2u o; o.x = pk2(y[0], y[1]); o.y = pk2(y[2], y[3]);
            *(v2u*)(YCAT + (row0 + t) * DM + 512 + h * 128 + 16 * wave + 4 * fq) = o;
        }
        __syncthreads();
    }
#pragma unroll
    for (int tb = 0; tb < 8; ++tb) { float s = sq[tb]; s += __shfl_xor(s, 16); s += __shfl_xor(s, 32); if (fq == 0) red[wave * 128 + 16 * tb + fr] = s; }
    __syncthreads();
    if (tid < 128) { float tot = 0.f;
#pragma unroll
        for (int w = 0; w < 8; ++w) tot += red[w * 128 + tid];
        GQ[row0 + tid] = tot; }
    __syncthreads();
}
__device__ __forceinline__ void gmlp_sample_item(LAS unsigned char* lds, int tid, int lane, int wave, int b, const bf16* VG, const bf16* UG,
                                                 const float* w_s, const float* g_v, const float* b_v, const float* b_s, bf16* YCAT, float* vs_out) {
    LAS float* red = (LAS float*)lds;
    const int c = tid, h = c >> 7;
    const size_t row0 = (size_t)MP + b * DECS;
    float vv[4], vn[4], y[4];
    const float gv = g_v[c], bv = b_v[c];
#pragma unroll
    for (int j = 0; j < 4; ++j) { vv[j] = bf1(VG[(row0 + j) * GMW + c]); const float s1 = wave_sum(vv[j]), s2 = wave_sum(vv[j] * vv[j]); if (lane == 0) { red[wave * 8 + 2 * j] = s1; red[wave * 8 + 2 * j + 1] = s2; } }
    __syncthreads();
#pragma unroll
    for (int j = 0; j < 4; ++j) { float s1 = 0.f, s2 = 0.f;
#pragma unroll
        for (int w = 0; w < 8; ++w) { s1 += red[w * 8 + 2 * j]; s2 += red[w * 8 + 2 * j + 1]; }
        const float m = s1 * (1.0f / 512.0f); float var = s2 * (1.0f / 512.0f) - m * m; var = var > 0.f ? var : 0.f;
        vn[j] = (vv[j] - m) * __builtin_amdgcn_rsqf(var + NORM_EPS) * gv + bv;
        vs_out[((size_t)b * DECS + j) * GMW + c] = vn[j]; }
    __syncthreads();
#pragma unroll
    for (int t = 0; t < 4; ++t) { float mix = b_s[h * CHUNK + t];
#pragma unroll
        for (int s = 0; s <= t; ++s) mix += w_s[((size_t)h * CHUNK + t) * CHUNK + s] * vn[s];
        y[t] = bf1(UG[(row0 + t) * GMW + c]) * mix; }
#pragma unroll
    for (int t = 0; t < 4; ++t) { const float s = wave_sum(y[t] * y[t]); if (lane == 0) red[wave * 4 + t] = s; }
    __syncthreads();
#pragma unroll
    for (int t = 0; t < 4; ++t) { float tot = 0.f;
#pragma unroll
        for (int w = 0; w < 8; ++w) tot += red[w * 4 + t];
        YCAT[(row0 + t) * DM + 512 + c] = (bf16)f2bf(y[t] * __builtin_amdgcn_rsqf(tot * (1.0f / 512.0f) + NORM_EPS)); }
    __syncthreads();
}

template <int TN, int WK, int WN, int K, int U, int MB = 2, bool PREBAR = false, class F>
__device__ __forceinline__ void small_gemm_tile(LAS unsigned char* lds, int tid, const bf16* A, int lda, const bf16* Bt, int row0, int col0, const F& f) {
    static_assert(WK * WN == 8 && TN % (16 * WN) == 0 && (K / WK) % (32 * U) == 0, "wave split");
    constexpr int NBW = TN / (16 * WN), P = TN + 4, KPER = K / WK;
    const int lane = tid & 63, wave = __builtin_amdgcn_readfirstlane(tid >> 6), wk = wave / WN, wn = wave % WN, fr = lane & 15, fq = lane >> 4;
    const int k0 = wk * KPER;
    f32x4 acc[MB][NBW];
#pragma unroll
    for (int m = 0; m < MB; ++m)
#pragma unroll
        for (int n = 0; n < NBW; ++n) acc[m][n] = (f32x4){0.f, 0.f, 0.f, 0.f};
    const bf16* ap = A + (size_t)(row0 + fr) * lda + k0 + 8 * fq;
    const bf16* bp = Bt + (size_t)(col0 + wn * (TN / WN) + fr) * K + k0 + 8 * fq;
    bf16x8 a0[2][U], a1[2][U], b[2][U][NBW];
#define SGT_LOAD(S_, KS_) do { _Pragma("unroll") for (int u = 0; u < U; ++u) { a0[S_][u] = *(const bf16x8*)(ap + (KS_) + 32 * u); if (MB == 2) a1[S_][u] = *(const bf16x8*)(ap + (size_t)16 * lda + (KS_) + 32 * u); \
        _Pragma("unroll") for (int n = 0; n < NBW; ++n) b[S_][u][n] = *(const bf16x8*)(bp + (size_t)n * 16 * K + (KS_) + 32 * u); } } while (0)
#define SGT_MMA(S_) do { _Pragma("unroll") for (int u = 0; u < U; ++u) _Pragma("unroll") for (int n = 0; n < NBW; ++n) { acc[0][n] = __builtin_amdgcn_mfma_f32_16x16x32_bf16(b[S_][u][n], a0[S_][u], acc[0][n], 0, 0, 0); \
        if (MB == 2) acc[MB - 1][n] = __builtin_amdgcn_mfma_f32_16x16x32_bf16(b[S_][u][n], a1[S_][u], acc[MB - 1][n], 0, 0, 0); } } while (0)
    constexpr bool ONEPASS = 16 * MB * (TN / 4) <= NWAVES * 64;
    typename F::Pre pre{};
    if constexpr (ONEPASS) { if (tid < 16 * MB * (TN / 4)) pre = f.prefetch(tid / (TN / 4), 4 * (tid % (TN / 4))); }
    SGT_LOAD(0, 0);
#pragma unroll 1
    for (int ks = 0; ks < KPER; ks += 64 * U) {
        if (ks + 32 * U < KPER) SGT_LOAD(1, ks + 32 * U);
        SGT_MMA(0);
        if (ks + 64 * U < KPER) SGT_LOAD(0, ks + 64 * U);
        if (ks + 32 * U < KPER) SGT_MMA(1);
    }
#undef SGT_LOAD
#undef SGT_MMA
    if constexpr (PREBAR) { asm volatile("s_waitcnt vmcnt(0)" ::: "memory"); __syncthreads(); }
    LAS float* red = (LAS float*)lds;
#pragma unroll
    for (int m = 0; m < MB; ++m)
#pragma unroll
        for (int n = 0; n < NBW; ++n) *(LAS f32x4*)(red + (size_t)((wk * 16 * MB + 16 * m + fr) * P + wn * (TN / WN) + 16 * n + 4 * fq)) = acc[m][n];
    __syncthreads();
#pragma unroll 1
    for (int e = tid; e < 16 * MB * (TN / 4); e += NWAVES * 64) { const int row = e / (TN / 4), c4 = 4 * (e % (TN / 4));
        f32x4 v = *(const LAS f32x4*)(red + (size_t)(row * P + c4));
#pragma unroll
        for (int w = 1; w < WK; ++w) v = v + *(const LAS f32x4*)(red + (size_t)((w * 16 * MB + row) * P + c4));
        if constexpr (ONEPASS) f(row, c4, v, pre); else f(row, c4, v, f.prefetch(row, c4)); }
    __syncthreads();
}
struct SF_In { int grow0, gcol0; const float* ssq; bf16* US; size_t seg_stride;
    struct Pre {}; __device__ __forceinline__ Pre prefetch(int, int) const { return Pre{}; }
    __device__ __forceinline__ void operator()(int row, int col, f32x4 v, const Pre&) const { const int gr = grow0 + row, gc = gcol0 + col, seg = gc >> 9, c = gc & 511;
        const float r = rinv16(ssq, gr, 1.0f / 1024.0f); v = v * r;
        if (seg != 0) { v[0] = gelu_tanh(v[0]); v[1] = gelu_tanh(v[1]); v[2] = gelu_tanh(v[2]); v[3] = gelu_tanh(v[3]); }
        v2u o; o.x = pk2(v[0], v[1]); o.y = pk2(v[2], v[3]);
        if (seg == 0) *(v2u*)(US + ((size_t)(c >> 4) * M + gr) * 16 + (c & 15)) = o;
        else *(v2u*)(US + (size_t)seg * seg_stride + (size_t)gr * 512 + c) = o; } };
struct SF_Plain { int grow0, gcol0; bf16* O; int ldo;
    struct Pre {}; __device__ __forceinline__ Pre prefetch(int, int) const { return Pre{}; }
    __device__ __forceinline__ void operator()(int row, int col, f32x4 v, const Pre&) const { v2u o; o.x = pk2(v[0], v[1]); o.y = pk2(v[2], v[3]); *(v2u*)(O + (size_t)(grow0 + row) * ldo + gcol0 + col) = o; } };
struct SF_Up { int grow0, gcol0; const float* ssq; bf16* HID;
    struct Pre {}; __device__ __forceinline__ Pre prefetch(int, int) const { return Pre{}; }
    __device__ __forceinline__ void operator()(int row, int col, f32x4 v, const Pre&) const { const int gr = grow0 + row; const float r = rinv16(ssq, gr, 1.0f / 1024.0f);
#pragma unroll
        for (int j = 0; j < 4; ++j) { const float a = fmaxf(v[j] * r, 0.f); v[j] = a * a; }
        v2u o; o.x = pk2(v[0], v[1]); o.y = pk2(v[2], v[3]); *(v2u*)(HID + (size_t)gr * FF + gcol0 + col) = o; } };
template <bool GATED, bool WT = false> struct SF_Res { int grow0, gcol0; const bf16* hin; bf16* hb; float* ssq_out; const float* ssq_in; const bf16* pl;
    struct Pre { v2u hq, pv; f32x4 s0, s1, s2, s3; };
    __device__ __forceinline__ Pre prefetch(int row, int col) const { Pre p{}; const int gr = grow0 + row; const size_t off = (size_t)gr * DM + gcol0 + col;
        p.hq = *(const v2u*)(hin + off);
        if (GATED) { p.pv = *(const v2u*)(pl + off); const f32x4* q = (const f32x4*)(ssq_in + (size_t)gr * 16); p.s0 = q[0]; p.s1 = q[1]; p.s2 = q[2]; p.s3 = q[3]; }
        return p; }
    __device__ __forceinline__ void operator()(int row, int col, f32x4 a, const Pre& p) const { const int gr = grow0 + row; const size_t off = (size_t)gr * DM + gcol0 + col;
        const v2u hq = p.hq; f32x4 hv = (f32x4){bflo(hq.x), bfhi(hq.x), bflo(hq.y), bfhi(hq.y)};
        if (GATED) { const float ss = ((p.s0[0] + p.s0[1]) + (p.s0[2] + p.s0[3])) + ((p.s1[0] + p.s1[1]) + (p.s1[2] + p.s1[3])) + ((p.s2[0] + p.s2[1]) + (p.s2[2] + p.s2[3])) + ((p.s3[0] + p.s3[1]) + (p.s3[2] + p.s3[3]));
            const float r = __builtin_amdgcn_rsqf(ss * (1.0f / 1024.0f) + NORM_EPS); const v2u pv = p.pv;
            a[0] = sigmoid_f(a[0] * r) * bflo(pv.x); a[1] = sigmoid_f(a[1] * r) * bfhi(pv.x); a[2] = sigmoid_f(a[2] * r) * bflo(pv.y); a[3] = sigmoid_f(a[3] * r) * bfhi(pv.y); }
        hv = hv + a; v2u o; o.x = pk2(hv[0], hv[1]); o.y = pk2(hv[2], hv[3]);
        if (WT) __hip_atomic_store((unsigned long long*)(hb + off), (unsigned long long)o.x | ((unsigned long long)o.y << 32), __ATOMIC_RELAXED, __HIP_MEMORY_SCOPE_AGENT); else *(v2u*)(hb + off) = o;
        float sq = (hv[0] * hv[0] + hv[1] * hv[1]) + (hv[2] * hv[2] + hv[3] * hv[3]);
        sq += __shfl_xor(sq, 1); sq += __shfl_xor(sq, 2); sq += __shfl_xor(sq, 4); sq += __shfl_xor(sq, 8);
        if ((col >> 2) == 0) { if (WT) __hip_atomic_store(&ssq_out[(size_t)gr * 16 + (gcol0 >> 6)], sq, __ATOMIC_RELAXED, __HIP_MEMORY_SCOPE_AGENT); else ssq_out[(size_t)gr * 16 + (gcol0 >> 6)] = sq; } } };
struct SF_Glu { LAS float* red; int grow0; const bf16* YS; const float* bias;
    struct Pre {}; __device__ __forceinline__ Pre prefetch(int, int) const { return Pre{}; }
    __device__ __forceinline__ void operator()(int row, int col, f32x4 v, const Pre&) const { const v2u yq = *(const v2u*)(YS + (size_t)(grow0 + row) * SSMW + col); const f32x4 b = *(const f32x4*)(bias + col);
        v[0] = bflo(yq.x) * sigmoid_f(v[0] + b[0]); v[1] = bfhi(yq.x) * sigmoid_f(v[1] + b[1]); v[2] = bflo(yq.y) * sigmoid_f(v[2] + b[2]); v[3] = bfhi(yq.y) * sigmoid_f(v[3] + b[3]);
        *(LAS f32x4*)(red + (size_t)(row * 516 + col)) = v; } };
#define SAMPLE_TILES_64(Aptr, lda_, Bptr, K_, U_, FUNCTOR_INIT) do { for (int t_ = bx; t_ < 256; t_ += G) { const int grow0 = MP + 32 * (t_ >> 4), gcol0 = 64 * (t_ & 15); \
        auto f_ = FUNCTOR_INIT; small_gemm_tile<64, 8, 1, K_, U_>(lds, tid, (Aptr), (lda_), (Bptr), grow0, gcol0, f_); } } while (0)
#define SAMPLE_TILES_64_PB(Aptr, lda_, Bptr, K_, U_, FUNCTOR_INIT) do { static_assert(true, ""); for (int t_ = bx; t_ < 256; t_ += G) { const int grow0 = MP + 32 * (t_ >> 4), gcol0 = 64 * (t_ & 15); \
        auto f_ = FUNCTOR_INIT; small_gemm_tile<64, 8, 1, K_, U_, 2, true>(lds, tid, (Aptr), (lda_), (Bptr), grow0, gcol0, f_); } \
        if (bx >= 256) { VM_WAIT(); __syncthreads(); }     } while (0)
#define FILL_RTAB(SCHED, SSQP) do { int t_ = threadIdx.x; asm volatile("" : "+v"(t_)); pg8::Unit u_; int ppm_ = -1; float pr_ = 0.f; \
        for (int i_ = 0; i_ < 8 && (SCHED).next(i_, u_); ++i_) { if (u_.pm != ppm_) { if (t_ < 256) pr_ = rinv16((SSQP), u_.pm * 256 + t_, 1.0f / 1024.0f); ppm_ = u_.pm; }     \
            if (t_ < 256) ((LAS float*)(lds + RT_OFF))[i_ * 256 + t_] = pr_; } \
        __syncthreads(); } while (0)

__device__ __forceinline__ void final_norm_rows(float* y, const bf16* hz, const float* ssq, const float* gf, int m_lo, int m_hi, int widx, int nw, int lane) {
    for (int m0 = m_lo + widx; m0 < m_hi; m0 += 3 * nw) {
        f32x4 sp[3][4]; v4u hq[3][2];
#pragma unroll
        for (int q = 0; q < 3; ++q) { const int m = m0 + q * nw; if (m < m_hi) { const f32x4* p = (const f32x4*)(ssq + (size_t)m * 16); sp[q][0] = p[0]; sp[q][1] = p[1]; sp[q][2] = p[2]; sp[q][3] = p[3];
            const GAS v4u* hr = (const GAS v4u*)(hz + (size_t)m * DM) + lane; hq[q][0] = hr[0]; hq[q][1] = hr[64]; } }
#pragma unroll
        for (int q = 0; q < 3; ++q) { const int m = m0 + q * nw; if (m < m_hi) { float s = 0.f;
#pragma unroll
            for (int j = 0; j < 4; ++j) s += (sp[q][j][0] + sp[q][j][1]) + (sp[q][j][2] + sp[q][j][3]);
            const float r = __builtin_amdgcn_rsqf(s * (1.0f / 1024.0f) + NORM_EPS);
            GAS f32x4* yr = (GAS f32x4*)(y + (size_t)m * DM); const GAS f32x4* gr = (const GAS f32x4*)gf;
#pragma unroll
            for (int j = 0; j < 2; ++j) { const v4u w = hq[q][j]; const int c = 2 * (lane + 64 * j);
                const f32x4 g0 = gr[c], g1 = gr[c + 1];
                yr[c] = (f32x4){bflo(w.x) * r * g0[0], bfhi(w.x) * r * g0[1], bflo(w.y) * r * g0[2], bfhi(w.y) * r * g0[3]};
                yr[c + 1] = (f32x4){bflo(w.z) * r * g1[0], bfhi(w.z) * r * g1[1], bflo(w.w) * r * g1[2], bfhi(w.w) * r * g1[3]}; } } }
    }
}
constexpr int CW_FIN = 16384, CW_FINS = CW_FIN + 64 * 64;
static_assert((CW_FINS + 16 * 64) * 4 <= (int)CTL_ZERO_BYTES, "control words");
namespace pg8 {
struct EpiFin {
    static constexpr bool PERM = true, AFTER_DRAIN = false, MIDSCALE = false, PREHOOK = true;
    const bf16_t* hin; float* ssq_out; const float* ssq_in; const bf16_t* pl; const PG8_LAS float* rtab; PG8_LAS float* rt2; float* y; const float* gfin; unsigned* cnt; unsigned* bar; unsigned nteam; PG8_LAS unsigned char* ring; RtPre pre = {};
    template <class Sched> __device__ __forceinline__ void prehook(const Sched& S, const Unit& u0) const { rtab_hook(S, u0, pre, ssq_in, (PG8_LAS float*)rtab); }
    __device__ __forceinline__ void operator()(const f32x4 (&acc_)[2][2][4][2], const Unit& u, int wr, int wc, int fr, int fq) const {
        f32x4 (&acc)[2][2][4][2] = const_cast<f32x4 (&)[2][2][4][2]>(acc_);
        int upm = u.pm, upn = u.pn; asm volatile("" : "+s"(upm), "+s"(upn));
        const int row0 = upm * BM + wr * 64 + fr, col0 = upn * BM + wc * 32 + 8 * fq;
        constexpr int NPF = 2;
#pragma unroll
        for (int ai = 0; ai < 2; ++ai)
#pragma unroll
            for (int mp = 0; mp < 4 / NPF; ++mp) {
                u32x4 hv[NPF][2]; u32x4 pv[NPF][2];
#pragma unroll
                for (int mm = 0; mm < NPF; ++mm) { const int row = row0 + ai * HALF + (NPF * mp + mm) * 16;
#pragma unroll
                    for (int bj = 0; bj < 2; ++bj) { const size_t off = (size_t)row * 1024 + col0 + bj * HALF; hv[mm][bj] = *(const u32x4*)(hin + off); pv[mm][bj] = *(const u32x4*)(pl + off); } }
#pragma unroll
                for (int mm = 0; mm < NPF; ++mm) { const int m = NPF * mp + mm, row = row0 + ai * HALF + m * 16;
                    const float r = (u.ui < 8) ? rtab[u.ui * 256 + wr * 64 + fr + ai * HALF + m * 16] : rinv16(ssq_in, row, 1.0f / 1024.0f);
                    float sq = 0.f;
#pragma unroll
                    for (int bj = 0; bj < 2; ++bj) {
                        f32x4 a0 = acc[ai][bj][m][0], a1 = acc[ai][bj][m][1]; const u32x4 hq = hv[mm][bj], p4 = pv[mm][bj];
                        f32x4 x0 = (f32x4){bf_lo(hq.x), bf_hi(hq.x), bf_lo(hq.y), bf_hi(hq.y)}, x1 = (f32x4){bf_lo(hq.z), bf_hi(hq.z), bf_lo(hq.w), bf_hi(hq.w)};
                        a0[0] = sigmoid_f(a0[0] * r) * bf_lo(p4.x); a0[1] = sigmoid_f(a0[1] * r) * bf_hi(p4.x); a0[2] = sigmoid_f(a0[2] * r) * bf_lo(p4.y); a0[3] = sigmoid_f(a0[3] * r) * bf_hi(p4.y);
                        a1[0] = sigmoid_f(a1[0] * r) * bf_lo(p4.z); a1[1] = sigmoid_f(a1[1] * r) * bf_hi(p4.z); a1[2] = sigmoid_f(a1[2] * r) * bf_lo(p4.w); a1[3] = sigmoid_f(a1[3] * r) * bf_hi(p4.w);
                        x0 = x0 + a0; x1 = x1 + a1;
                        acc[ai][bj][m][0] = x0; acc[ai][bj][m][1] = x1;
                        sq += ((x0[0] * x0[0] + x0[1] * x0[1]) + (x0[2] * x0[2] + x0[3] * x0[3])) + ((x1[0] * x1[0] + x1[1] * x1[1]) + (x1[2] * x1[2] + x1[3] * x1[3])); }
                    sq += __shfl_xor(sq, 16); sq += __shfl_xor(sq, 32);
                    if (fq == 0) __hip_atomic_store(&ssq_out[(size_t)row * 16 + upn * 4 + wc], sq, __ATOMIC_RELAXED, __HIP_MEMORY_SCOPE_AGENT); }
                asm volatile("" ::: "memory");
            }
        asm volatile("s_waitcnt vmcnt(0)" ::: "memory");
        __syncthreads();
        if (threadIdx.x == 0) {
            (void)xb_add(&cnt[upm * 64], 1u);
            XB_SPIN(xb_ld(&cnt[upm * 64]) < nteam, bar);
            __builtin_amdgcn_fence(__ATOMIC_ACQUIRE, "agent");
            asm volatile("s_waitcnt vmcnt(0)" ::: "memory");
        }
        __syncthreads();
        { int t_ = threadIdx.x; asm volatile("" : "+v"(t_)); if (t_ < 256) rt2[t_] = rinv16(ssq_out, upm * BM + t_, 1.0f / 1024.0f); }
        __syncthreads();
        f32x4 gq[2][2];
#pragma unroll
        for (int bj = 0; bj < 2; ++bj) { gq[bj][0] = *(const f32x4*)(gfin + col0 + bj * HALF); gq[bj][1] = *(const f32x4*)(gfin + col0 + bj * HALF + 4); }
        PG8_LAS float* stg = (PG8_LAS float*)ring; const int wave = wr * 4 + wc, lane = fr + 16 * fq;
#pragma unroll
        for (int ai = 0; ai < 2; ++ai) {
#pragma unroll
            for (int m = 0; m < 4; ++m) { const int rl = wr * 64 + m * 16 + fr; const float r = rt2[rl + ai * HALF];
#pragma unroll
                for (int bj = 0; bj < 2; ++bj)
#pragma unroll
                    for (int n = 0; n < 2; ++n) { const int c16 = (bj * 32 + wc * 8 + 2 * fq + n) ^ fr;
                        *(PG8_LAS f32x4*)(stg + rl * 256 + c16 * 4) = acc[ai][bj][m][n] * r * gq[bj][n]; } }
            __syncthreads();
#pragma unroll 4
            for (int rr = 0; rr < 16; ++rr) { const int rl = wave * 16 + rr; const f32x4 v = *(const PG8_LAS f32x4*)(stg + rl * 256 + lane * 4);
                *(f32x4*)(y + (size_t)(upm * BM + ai * HALF + rl) * 1024 + upn * BM + 4 * (lane ^ (rl & 15))) = v; }
            __syncthreads();
        }
    }
};
}
__global__ void __launch_bounds__(NWAVES * 64, 2) hymba_fwd(Args args) {
    extern __shared__ __attribute__((aligned(16))) unsigned char lds_raw[];
    LAS unsigned char* lds = (LAS unsigned char*)lds_raw;
    volatile LAS unsigned* MISC = (volatile LAS unsigned*)(lds + MISC_OFF);
    const int tid = threadIdx.x, lane = tid & 63, wave = __builtin_amdgcn_readfirstlane(tid >> 6);
    const int G = gridDim.x, bx = blockIdx.x;
    const bool FUSED_FINAL = (N_LAUNCHES == 1) && G == (MP / 256) * (DM / 256);
    unsigned char* ws = args.ws;
    gu32* ctl = (gu32*)(ws + WS_CTL);
    for (int u = tid; u < (LDS_BYTES - LDSCTL_OFF) / 4; u += NWAVES * 64) ((LAS unsigned*)(lds + LDSCTL_OFF))[u] = 0u;
    __syncthreads();
    XcdBarrier bar; bar.bar = (unsigned*)(ctl + CW_BAR); bar.x = 0; bar.st = nullptr;
    if (N_LAUNCHES == 1) bar = xcd_barrier_post((unsigned*)(ctl + CW_BAR), MISC + 8);
#define GRID_BAR() do { if (N_LAUNCHES == 1) xcd_barrier(bar); } while (0)
    const int lo = args.ph_lo, hi = args.ph_hi;
#define IN(k) (lo <= (k) && (k) < hi)
#define BOTH(k) (IN(k) && IN((k) + 1))

#define PHASE_PTRS() unsigned char* ws = args.ws; float* out_ = args.out; asm volatile("" : "+s"(ws), "+s"(out_)); \
    float* hres = out_ + O_Y; bf16* HB = (bf16*)(ws + WS_HB); bf16* PL = (bf16*)(ws + WS_PL); \
    float* VST = (float*)(ws + WS_VST); float* GS = (float*)(ws + WS_GS); \
    bf16* US = (bf16*)(ws + WS_OVL + OV_US); bf16* UG = (bf16*)(ws + WS_OVL + OV_UG); bf16* VG = (bf16*)(ws + WS_OVL + OV_VG); bf16* YS = (bf16*)(ws + WS_OVL + OV_YS); \
    bf16* YCAT = (bf16*)(ws + WS_OVL + OV_YCAT); bf16* PB = (bf16*)((unsigned char*)out_ + 36 * MiB);     bf16* HID = (bf16*)(ws + WS_OVL); \
    bf16* HBY = (bf16*)out_; bf16* HBZ = (bf16*)(ws + WS_OVL); const bf16* HIN = (L == 0) ? HB : HBY; bf16* HOUT7 = (L == DEPTH - 1) ? HBZ : HBY; \
    const unsigned char* wl = ws + WS_W + (size_t)L * W_LAYER; \
    float* SA = (float*)(ws + ((L & 1) ? WS_SSQ1 : WS_SSQ0)); float* SB = (float*)(ws + ((L & 1) ? WS_SSQ0 : WS_SSQ1)); \
    const float* tb = (const float*)(ws + WS_TB) + (size_t)L * TB_LAYER; \
    (void)hres; (void)HB; (void)PL; (void)VST; (void)GS; (void)US; (void)UG; (void)VG; (void)YS; (void)YCAT; (void)PB; (void)HID; (void)HBY; (void)HBZ; (void)HIN; (void)HOUT7; (void)wl; (void)SA; (void)SB; (void)tb

    if (PHON(0) && IN(0)) { p0_prologue(args, lds, tid, lane, wave, bx, G); if (BOTH(0)) GRID_BAR(); }

#pragma unroll 1
    for (int L = 0; L < DEPTH; ++L) {
        const int pb = 1 + 7 * L;
        if (PHON(1) && IN(pb + 0)) {
            PHASE_PTRS();
            const bool conv_first = ((bx >> 3) & 1) != 0;
#pragma unroll 1
            for (int s_ = 0; s_ < 2; ++s_) {
                if (L == 0 && (s_ == 0) == conv_first) { int tid = threadIdx.x; asm volatile("" : "+v"(tid)); const int lane = tid & 63, wave = __builtin_amdgcn_readfirstlane(tid >> 6);
                    __syncthreads(); p0_convert(args, lds, lane, wave, bx * NWAVES + wave, G * NWAVES, P0_I_IN, P0_I_LAYER); __syncthreads(); }
                if (s_ != 0) continue;
            pg8::Gemm g{HIN, (const bf16*)(wl + WO_IN), MP, INW, opq(DM), 0, 0, (bx & 7) * 2}; pg8::StaticOrder S; S.init(MP, INW, G, bx);
            pg8::EpiAct<0> E{US, SSMW, (OV_UG - OV_US) / 2, M, SA, VST, nullptr, nullptr, (const LAS float*)(lds + RT_OFF)};
            { int t_ = threadIdx.x; asm volatile("" : "+v"(t_)); pg8::Unit u0_; if (S.next(0, u0_) && t_ < 256) E.pre = pg8::rtpre_load(SA, u0_.pm * 256 + t_); }
            pg8::gemm_phase<pg8::EpiAct<0>, pg8::StaticOrder, PG8_ALIGN, PG8_SP2>(lds, g, S, E);
            { int tid = threadIdx.x; asm volatile("" : "+v"(tid));
              for (int t_ = bx; t_ < 256; t_ += G) { const int grow0 = MP + 32 * (t_ >> 4), gcol0 = 96 * (t_ & 15);
                  SF_In f_{grow0, gcol0, SA, US, (OV_UG - OV_US) / 2}; small_gemm_tile<96, 8, 1, DM, 4>(lds, tid, HIN, DM, (const bf16*)(wl + WO_IN), grow0, gcol0, f_); } }
            { int tid = threadIdx.x; asm volatile("" : "+v"(tid));
              const int half = G / 2;
              if (bx >= half) s5_build_tables((bx - half) * (NWAVES * 64) + tid, (G - half) * NWAVES * 64, tb, (const float*)(ws + WS_LPOW) + (size_t)L * NG * (S5T + 1) * NP * 2,
                                              args.in[I_CRE] + (size_t)L * NG * GC * NP, args.in[I_CIM] + (size_t)L * NG * GC * NP,
                                              (bf16*)(ws + WS_OVL + OV_FT), (bf16*)(ws + WS_OVL + OV_WT), (bf16*)(ws + WS_OVL + OV_GT)); }
            { int tid = threadIdx.x; asm volatile("" : "+v"(tid));
              const int e0 = bx * (NWAVES * 64) + tid, NE = G * NWAVES * 64;
              const float* __restrict__ pp = args.in[I_PP] + (size_t)L * MP * PLE; bf16* __restrict__ pbo = PB;
#pragma unroll 4
              for (int e = e0; e < MP * (PLE / 8); e += NE) { const f32x4 a = *(const f32x4*)(pp + (size_t)e * 8), c = *(const f32x4*)(pp + (size_t)e * 8 + 4);
                  v4u o; o.x = pk2(a[0], a[1]); o.y = pk2(a[2], a[3]); o.z = pk2(c[0], c[1]); o.w = pk2(c[2], c[3]); *(v4u*)(pbo + (size_t)e * 8) = o; }
              const float* psm = args.in[I_PS] + (size_t)L * MS * PLE;
              for (int e = e0; e < MS * (PLE / 8); e += NE) { const f32x4 a = *(const f32x4*)(psm + (size_t)e * 8), c = *(const f32x4*)(psm + (size_t)e * 8 + 4);
                  v4u o; o.x = pk2(a[0], a[1]); o.y = pk2(a[2], a[3]); o.z = pk2(c[0], c[1]); o.w = pk2(c[2], c[3]); *(v4u*)(PB + (size_t)MP * PLE + (size_t)e * 8) = o; }
            }
            }
            if (BOTH(pb + 0)) GRID_BAR();
        }
        if (PHON(2) && IN(pb + 1)) {
            PHASE_PTRS();
            const bool conv_first = ((bx >> 3) & 1) != 0;
#pragma unroll 1
            for (int s_ = 0; s_ < 2; ++s_) {
                if (L == 0 && (s_ == 0) == conv_first) { int tid = threadIdx.x; asm volatile("" : "+v"(tid)); const int lane = tid & 63, wave = __builtin_amdgcn_readfirstlane(tid >> 6);
                    __syncthreads(); p0_convert(args, lds, lane, wave, bx * NWAVES + wave, G * NWAVES, P0_I_LAYER, DEPTH * P0_I_LAYER); __syncthreads(); }
                if (s_ != 0) continue;
            int tid = threadIdx.x; asm volatile("" : "+v"(tid)); const int lane = tid & 63, wave = __builtin_amdgcn_readfirstlane(tid >> 6);
            const float* cre = args.in[I_CRE] + (size_t)L * NG * GC * NP; const float* cim = args.in[I_CIM] + (size_t)L * NG * GC * NP; const float* dsk = args.in[I_DSK] + L * SSMW;
            for (int it = bx; it < NBATCH * NG; it += G) { const int n = it >> 5, g = it & 31;
                s5_prompt_item_mfma(lds, tid, lane, wave, n, g, US, (const bf16*)(ws + WS_OVL + OV_FT) + (size_t)g * S5T * 512, (const bf16*)(ws + WS_OVL + OV_WT) + (size_t)g * 8 * 16 * 512,
                                    (const bf16*)(ws + WS_OVL + OV_GT) + (size_t)g * S5T * 4 * 512, (const float*)(ws + WS_LPOW) + (((size_t)L * NG + g) * (S5T + 1) + S5T) * NP * 2, dsk + g * 16,
                                    YS, args.out + O_REP + ((size_t)(L * NBATCH + n) * NG + g) * NP, args.out + O_IMP + ((size_t)(L * NBATCH + n) * NG + g) * NP);
            }
            for (int it = bx * NWAVES + wave; it < DECB * NG; it += G * NWAVES) { const int g = it & 31, b = it >> 5;
                s5_sample_wave(lane, b, g, tb, cre, cim, dsk, US, YS, args.in[I_STRE] + (size_t)L * DECB * NG * NP, args.in[I_STIM] + (size_t)L * DECB * NG * NP,
                               args.out + O_RES + (size_t)L * DECB * NG * NP, args.out + O_IMS + (size_t)L * DECB * NG * NP); }
            __syncthreads();
            for (int it = bx; it < 2 * (MP / CHUNK); it += G)
                gmlp_prompt_item(lds, tid, lane, wave, (size_t)(it >> 1) * CHUNK, VG, UG, VST, (const bf16*)(ws + WS_WSM) + (size_t)L * NH * CHUNK * CHUNK, (const float*)(ws + WS_WSUM) + (size_t)L * NH * CHUNK,
                                 args.in[I_GV] + L * GMW, args.in[I_BV] + L * GMW, args.in[I_BS] + L * NH * CHUNK, YCAT, (float*)(ws + WS_GQ) + (size_t)(it & 1) * MP, (it & 1) * 2);
            }
            if (BOTH(pb + 1)) GRID_BAR();
        }
        if (PHON(3) && IN(pb + 2)) {
            PHASE_PTRS();
            int tid = threadIdx.x; asm volatile("" : "+v"(tid)); const int lane = tid & 63, wave = __builtin_amdgcn_readfirstlane(tid >> 6);
            constexpr int NGLU = (MP / 256) * (SSMW / 256);
            const bool split = G >= NGLU + 128;
            if (!split || bx < NGLU) {
                pg8::Gemm g{YS, (const bf16*)(wl + WO_GLU), MP, SSMW, opq(SSMW)}; pg8::StaticOrder S; S.init(MP, SSMW, split ? NGLU : G, bx);
                pg8::EpiAct<2> E{YCAT, DM, 0, 0, nullptr, GS, YS, args.in[I_BGLU] + L * SSMW, nullptr};
                pg8::gemm_phase<pg8::EpiAct<2>, pg8::StaticOrder, PG8_ALIGN, PG8_SP2>(lds, g, S, E);
            }
            {
                const bf16* wsm = (const bf16*)(ws + WS_WSM) + (size_t)L * NH * CHUNK * CHUNK;
                const float* g_v = args.in[I_GV] + L * GMW; const float* b_v = args.in[I_BV] + L * GMW; const float* b_s = args.in[I_BS] + L * NH * CHUNK;
                if (!split || bx >= NGLU) for (int k_ = 0; k_ < (split ? 2 : (DECB + 32 + G - 1) / G); ++k_) { const int bz = bx - NGLU;
                    int it; if (split) { it = (bz >= 96) ? (k_ == 0 ? 128 + DECB + (bz - 96) : -1) : (k_ == 0 ? 128 + bz : (bz < 32 ? 128 + 96 + bz : -1)); } else it = 128 + bx + k_ * G;
                    if (it < 0 || it >= 128 + DECB + 32) continue;
                    if (it < 128 + DECB) gmlp_sample_item(lds, tid, lane, wave, it - 128, VG, UG, args.in[I_WS] + (size_t)L * NH * CHUNK * CHUNK, g_v, b_v, b_s, YCAT, args.out + O_VS + (size_t)L * DECB * DECS * GMW);
                    else {
                        const int grow0 = MP + 16 * (it - 128 - DECB); LAS float* red = (LAS float*)lds;
                        SF_Glu f_{red, grow0, YS, args.in[I_BGLU] + L * SSMW}; small_gemm_tile<512, 1, 8, SSMW, 2, 1>(lds, tid, YS, SSMW, (const bf16*)(wl + WO_GLU), grow0, 0, f_);
                        for (int r4 = 0; r4 < 2; ++r4) { const int row = wave * 2 + r4; const LAS f32x4* rp = (const LAS f32x4*)(red + (size_t)row * 516) + lane; const f32x4 a = rp[0], b2 = rp[64];
                            float sq = ((a[0] * a[0] + a[1] * a[1]) + (a[2] * a[2] + a[3] * a[3])) + ((b2[0] * b2[0] + b2[1] * b2[1]) + (b2[2] * b2[2] + b2[3] * b2[3]));
                            const float r = __builtin_amdgcn_rsqf(wave_sum(sq) * (1.0f / 512.0f) + NORM_EPS);
                            v2u o0, o1; o0.x = pk2(a[0] * r, a[1] * r); o0.y = pk2(a[2] * r, a[3] * r); o1.x = pk2(b2[0] * r, b2[1] * r); o1.y = pk2(b2[2] * r, b2[3] * r);
                            v2u* yp = (v2u*)(YCAT + (size_t)(grow0 + row) * DM) + lane; yp[0] = o0; yp[64] = o1; }
                        __syncthreads();
                    }
                }
            }
            if (BOTH(pb + 2)) GRID_BAR();
        }
        if (PHON(4) && IN(pb + 3)) {
            PHASE_PTRS();
            pg8::Gemm g{YCAT, (const bf16*)(wl + WO_OUT), MP, DM, opq(DM)}; pg8::StaticOrder S; S.init(MP, DM, G, bx);
            pg8::EpiRes<false, true> E{HIN, HB, SB, nullptr, nullptr, 0, (const LAS float*)(lds + RT_OFF), {}, GS, (const float*)(ws + WS_GQ), MP};
            { int t_ = threadIdx.x; asm volatile("" : "+v"(t_)); pg8::Unit u0_; if (S.next(0, u0_) && t_ < 256) { const size_t row = (size_t)u0_.pm * 256 + t_; const float* GQp = (const float*)(ws + WS_GQ);
                E.pre.a = *(const f32x4*)(GS + row * 8); E.pre.b = *(const f32x4*)(GS + row * 8 + 4); E.pre.c = (f32x4){GQp[row], GQp[MP + row], 0.f, 0.f}; } }
            const bool tile_first = ((bx >> 3) & 1) != 0;
#pragma unroll 1
            for (int s_ = 0; s_ < 2; ++s_) {
                if ((s_ == 0) != tile_first) pg8::gemm_phase<pg8::EpiRes<false, true>, pg8::StaticOrder, PG8_ALIGN, PG8_SP2, false>(lds, g, S, E);
                else { int tid = threadIdx.x; asm volatile("" : "+v"(tid)); SAMPLE_TILES_64_PB(YCAT, DM, (const bf16*)(wl + WO_OUT), DM, 4, (SF_Res<false>{grow0, gcol0, HIN, HB, SB, nullptr, nullptr})); }
            }
            if (BOTH(pb + 3)) GRID_BAR();
        }
        if (PHON(5) && IN(pb + 4)) {
            PHASE_PTRS();
            const bool ple_first = ((bx >> 3) & 1) != 0;
#pragma unroll 1
            for (int s_ = 0; s_ < 3; ++s_) {
                if (s_ == 1) {
                    pg8::Gemm g{HB, (const bf16*)(wl + WO_UP), MP, FF, opq(DM), 0, 0, (bx & 7) * 2, HB + (size_t)MP * DM, DM}; pg8::RevOrder S; S.init_rev(MP, FF, G, bx);
                    pg8::EpiAct<1> E{HID, 256, 0, FF / 256, SB, nullptr, nullptr, nullptr, (const LAS float*)(lds + RT_OFF), HID + (size_t)MP * FF, FF, MP};
                    { int t_ = threadIdx.x; asm volatile("" : "+v"(t_)); pg8::Unit u0_; if (S.next(0, u0_) && t_ < 256) E.pre = pg8::rtpre_load(SB, u0_.pm * 256 + t_); }
                    pg8::gemm_phase<pg8::EpiAct<1>, pg8::RevOrder, PG8_ALIGN, PG8_SP2, true, true>(lds, g, S, E);
                } else {
                    if ((s_ == 0) == ple_first) {
                        pg8::Gemm g{PB, (const bf16*)(wl + WO_PLE), MP, DM, opq(PLE), 0, 0, 0, PB + (size_t)MP * PLE, PLE}; pg8::StaticOrder S; S.init(MP, DM, G, bx);
                        pg8::EpiAct<3> E{PL, DM, 0, 0, nullptr, nullptr, nullptr, nullptr, nullptr, PL + (size_t)MP * DM, DM, MP};
                        pg8::gemm_phase<pg8::EpiAct<3>, pg8::StaticOrder, PG8_ALIGN, PG8_SP2, true, true>(lds, g, S, E);
                    }
                }
            }
            if (BOTH(pb + 4)) GRID_BAR();
        }
        if (PHON(6) && IN(pb + 5)) {
            PHASE_PTRS();
            pg8::Gemm g{HID, (const bf16*)(wl + WO_DN), MP, DM, opq(FF), 256, 131072, (bx & 7) * 8}; pg8::StaticOrder S; S.init(MP, DM, G, bx);
            pg8::EpiRes<false> E{HB, HB, SA, nullptr, nullptr, 0, nullptr};
            const bool tile_first = ((bx >> 3) & 1) != 0;
#pragma unroll 1
            for (int s_ = 0; s_ < 2; ++s_) {
                if ((s_ == 0) != tile_first) pg8::gemm_phase<pg8::EpiRes<false>, pg8::StaticOrder, PG8_ALIGN, PG8_SP2, false>(lds, g, S, E);
                else { int tid = threadIdx.x; asm volatile("" : "+v"(tid)); SAMPLE_TILES_64_PB(HID, FF, (const bf16*)(wl + WO_DN), FF, 2, (SF_Res<false>{grow0, gcol0, HB, HB, SA, nullptr, nullptr})); }
            }
            if (BOTH(pb + 5)) GRID_BAR();
        }
        if (PHON(7) && IN(pb + 6)) {
            PHASE_PTRS();
            pg8::Gemm g{HB, (const bf16*)(wl + WO_PG), MP, DM, opq(DM), 0, 0, (bx & 7) * 2}; pg8::StaticOrder S; S.init(MP, DM, G, bx);
            const bool tile_first = ((bx >> 3) & 1) != 0;
            const bool fin = FUSED_FINAL && L == DEPTH - 1;
            if (!fin) {
                pg8::EpiRes<true> E{HB, HOUT7, SB, SA, PL, 0, (const LAS float*)(lds + RT_OFF)};
                { int t_ = threadIdx.x; asm volatile("" : "+v"(t_)); pg8::Unit u0_; if (S.next(0, u0_) && t_ < 256) E.pre = pg8::rtpre_load(SA, u0_.pm * 256 + t_); }
#pragma unroll 1
                for (int s_ = 0; s_ < 2; ++s_) {
                    if ((s_ == 0) != tile_first) pg8::gemm_phase<pg8::EpiRes<true>, pg8::StaticOrder, PG8_ALIGN, PG8_SP2, false>(lds, g, S, E);
                    else { int tid = threadIdx.x; asm volatile("" : "+v"(tid)); SAMPLE_TILES_64_PB(HB, DM, (const bf16*)(wl + WO_PG), DM, 4, (SF_Res<true>{grow0, gcol0, HB, HOUT7, SB, SA, PL})); }
                }
            } else {
                unsigned* ctlw = (unsigned*)(ws + WS_CTL);
                pg8::EpiFin E{HB, SB, SA, PL, (const LAS float*)(lds + RT_OFF), (LAS float*)(lds + RT_OFF) + 1024, out_ + O_Y, args.in[I_GFIN], ctlw + CW_FIN, ctlw + CW_BAR, (unsigned)(DM / 256), lds};
                { int t_ = threadIdx.x; asm volatile("" : "+v"(t_)); pg8::Unit u0_; if (S.next(0, u0_) && t_ < 256) E.pre = pg8::rtpre_load(SA, u0_.pm * 256 + t_); }
#pragma unroll 1
                for (int s_ = 0; s_ < 2; ++s_) {
                    if ((s_ == 0) != tile_first) pg8::gemm_phase<pg8::EpiFin, pg8::StaticOrder, PG8_ALIGN, PG8_SP2, false>(lds, g, S, E);
                    else { int tid = threadIdx.x; asm volatile("" : "+v"(tid)); const int lane = tid & 63, wave = __builtin_amdgcn_readfirstlane(tid >> 6);
                        SAMPLE_TILES_64_PB(HB, DM, (const bf16*)(wl + WO_PG), DM, 4, (SF_Res<true, true>{grow0, gcol0, HB, HOUT7, SB, SA, PL}));
                        for (int t_ = bx; t_ < 256; t_ += G) { const int rb = t_ >> 4;
                            asm volatile("s_waitcnt vmcnt(0)" ::: "memory");
                            __syncthreads();
                            if (tid == 0) {
                                const unsigned old = xb_add(ctlw + CW_FINS + rb * 64, 1u);
                                if (old == 15u) { __builtin_amdgcn_fence(__ATOMIC_ACQUIRE, "agent"); asm volatile("s_waitcnt vmcnt(0)" ::: "memory"); }
                                MISC[16] = (old == 15u) ? 1u : 0u; }
                            __syncthreads();
                            if (MISC[16] != 0u) final_norm_rows(out_ + O_Y, HOUT7, SB, args.in[I_GFIN], MP + 32 * rb, MP + 32 * rb + 32, wave, NWAVES, lane);
                            __syncthreads(); }
                    }
                }
            }
            if (BOTH(pb + 6) && !(FUSED_FINAL && L == DEPTH - 1)) GRID_BAR();
        }
    }
    if (PHON(8) && IN(15) && !FUSED_FINAL) {
        int tid = threadIdx.x; asm volatile("" : "+v"(tid)); const int lane = tid & 63, wave = __builtin_amdgcn_readfirstlane(tid >> 6);
        final_norm_rows(args.out + O_Y, (const bf16*)(args.ws + WS_OVL), (const float*)(args.ws + ((DEPTH & 1) ? WS_SSQ1 : WS_SSQ0)), args.in[I_GFIN], 0, M, bx * NWAVES + wave, G * NWAVES, lane);
    }
    asm volatile("s_waitcnt vmcnt(0)" ::: "memory");
#undef IN
#undef BOTH
}

extern "C" void kernel_launch(void* const* d_in, const int* in_sizes, int n_in, void* d_out, int out_size, void* d_ws, size_t ws_size, hipStream_t stream) {
    static int grid = 0;
    if (grid == 0) {
        if (n_in != N_IN || in_sizes[0] != MP * DM || (size_t)out_size != O_END || ws_size < WS_END) {
            fprintf(stderr, "kernel_launch: built for %d inputs, out of %zu floats, >= %zu bytes of workspace; got n_in %d, in0 %d, out %d, ws %zu; nothing launched\n", (int)N_IN, (size_t)O_END, (size_t)WS_END, n_in, n_in > 0 ? in_sizes[0] : -1, out_size, ws_size); grid = -1; return; }
        int dev = 0, cus = 0, per_cu = 0;
        if (hipGetDevice(&dev) != hipSuccess || hipDeviceGetAttribute(&cus, hipDeviceAttributeMultiprocessorCount, dev) != hipSuccess) { fprintf(stderr, "kernel_launch: hipGetDevice / hipDeviceGetAttribute failed\n"); grid = -1; return; }
        if (hipFuncSetAttribute((const void*)hymba_fwd, hipFuncAttributeMaxDynamicSharedMemorySize, LDS_BYTES) != hipSuccess) { fprintf(stderr, "kernel_launch: hipFuncSetAttribute failed\n"); grid = -1; return; }
        if (hipOccupancyMaxActiveBlocksPerMultiprocessor(&per_cu, (const void*)hymba_fwd, NWAVES * 64, LDS_BYTES) != hipSuccess || per_cu < 1)
            fprintf(stderr, "kernel_launch: note: occupancy query reports %d workgroups per CU\n", per_cu);
        (void)hipGetLastError();
        grid = cus;
    }
    if (grid < 0) return;
    if (hipMemsetAsync((char*)d_ws + WS_CTL, 0, CTL_ZERO_BYTES, stream) != hipSuccess) { fprintf(stderr, "kernel_launch: hipMemsetAsync failed\n"); return; }
    Args a{};
    for (int i = 0; i < N_IN; ++i) a.in[i] = (const float*)d_in[i];
    a.out = (float*)d_out; a.ws = (unsigned char*)d_ws;
    for (int li = 0; li < N_LAUNCHES; ++li) {
        a.ph_lo = (N_LAUNCHES == 1) ? 0 : li; a.ph_hi = (N_LAUNCHES == 1) ? NPH : li + 1; a.li = li;
        hipLaunchKernelGGL(hymba_fwd, dim3(grid), dim3(NWAVES * 64), LDS_BYTES, stream, a);
        const hipError_t le = hipPeekAtLastError();
        if (le != hipSuccess) { fprintf(stderr, "kernel_launch: launch %d failed: %s\n", li, hipGetErrorName(le)); break; }
    }
}
```

```cpp
#include <hip/hip_runtime.h>
#include <cstdio>
#include <cstdint>

typedef unsigned fshx_u2 __attribute__((ext_vector_type(2)));
template <int M> __device__ __forceinline__ float fshx(float x) {
    const unsigned u = __builtin_bit_cast(unsigned, x);
    if constexpr (M == 1) return __builtin_bit_cast(float, __builtin_amdgcn_update_dpp(0u, u, 0xB1, 0xF, 0xF, true));
    else if constexpr (M == 2) return __builtin_bit_cast(float, __builtin_amdgcn_update_dpp(0u, u, 0x4E, 0xF, 0xF, true));
    else if constexpr (M == 4) { const unsigned t = __builtin_amdgcn_update_dpp(0u, u, 0x141, 0xF, 0xF, true);
        return __builtin_bit_cast(float, __builtin_amdgcn_update_dpp(0u, t, 0x1B, 0xF, 0xF, true)); }
    else if constexpr (M == 8) return __builtin_bit_cast(float, __builtin_amdgcn_update_dpp(0u, u, 0x128, 0xF, 0xF, true));
    else { static_assert(M == 16 || M == 32, "fshx: mask");
        const unsigned lane = __builtin_amdgcn_mbcnt_hi(~0u, __builtin_amdgcn_mbcnt_lo(~0u, 0u));
        const fshx_u2 r = (M == 16) ? __builtin_amdgcn_permlane16_swap(u, u, false, false) : __builtin_amdgcn_permlane32_swap(u, u, false, false);
        return __builtin_bit_cast(float, (lane & (unsigned)M) ? r.x : r.y); }
}
namespace pg8 {
#define PG8_LAS __attribute__((address_space(3)))
typedef unsigned short bf16_t;
typedef short bf16x8 __attribute__((ext_vector_type(8)));
typedef float f32x4 __attribute__((ext_vector_type(4)));
typedef unsigned u32x4 __attribute__((ext_vector_type(4)));
constexpr int BM = 256, BK = 64, HALF = 128, HTB = HALF * BK * 2  , STAGE_BYTES = 8 * HTB, NXCD = 8, WGM = 8;
constexpr int XR_OFF = STAGE_BYTES + 9216;

__host__ __device__ __forceinline__ int lds_byte(int r, int c) { const int st = (r >> 4) * 2 + (c >> 5), rr = r & 15, cc = c & 31, ob = rr * 64 + cc * 2; return st * 1024 + (ob ^ (((ob >> 9) & 1) << 5)); }
__host__ __device__ __forceinline__ void stage_rc(int b, int& R, int& C) { const int st = b / 1024, sb = b % 1024, swz = sb ^ (((sb >> 9) & 1) << 5); R = (st >> 1) * 16 + swz / 64; C = (st & 1) * 32 + (swz % 64) / 2; }
__host__ __device__ __forceinline__ int perm32(int rho) { const int n = rho >> 4, i = rho & 15; return 8 * (i >> 2) + 4 * n + (i & 3); }

struct Unit { int pm, pn, ui; };
struct Gemm { const bf16_t* A; const bf16_t* Bt; int M, N, K; int lda = 0; int kblk = 0; int t0 = 0; const bf16_t* Ax = nullptr; int ldax = 0; };

struct StaticOrder {
    int nM, nN, nwg, G, c;
    __host__ __device__ __forceinline__ void init(int M, int N, int G_, int c_) { nM = M / BM; nN = N / BM; nwg = nM * nN; G = G_; c = c_; }
    __host__ __device__ __forceinline__ bool next(int i, Unit& u) const {
        const long L = (long)i * G + c; if (L >= nwg) return false;
        int wgid = (int)L; { const int q = nwg / NXCD, r = nwg % NXCD, xcd = wgid % NXCD, off = wgid / NXCD; wgid = (xcd < r ? xcd * (q + 1) : r * (q + 1) + (xcd - r) * q) + off; }
        const int nig = WGM * nN, gid = wgid / nig, fm = gid * WGM, gsz = (nM - fm) < WGM ? (nM - fm) : WGM;
        u.pm = fm + ((wgid % nig) % gsz); u.pn = (wgid % nig) / gsz; u.ui = i; return true;
    }
    __device__ __forceinline__ void a_ready(const Unit&) const {}
    __device__ __forceinline__ void done(const Unit&) const {}
};


#ifndef WT_STORES
#define WT_STORES 0
#endif
__device__ __forceinline__ unsigned cvt_pk_bf16(float lo, float hi) { unsigned r; asm volatile("v_cvt_pk_bf16_f32 %0, %1, %2" : "=v"(r) : "v"(lo), "v"(hi)); return r; }
typedef float f32x2 __attribute__((ext_vector_type(2)));

typedef unsigned u32x2 __attribute__((ext_vector_type(2)));
__device__ __forceinline__ void store16_wt(void* p, u32x4 v) {
#if WT_STORES
    asm volatile("global_store_dwordx4 %0, %1, off sc1\n\ts_nop 1" :: "v"(p), "v"(v) : "memory");
#else
    *(u32x4*)p = v;
#endif
}
constexpr float NORM_EPS = 1e-6f;
constexpr float LOG2E = 1.4426950408889634f;
__device__ __forceinline__ float bf_lo(unsigned w) { return __uint_as_float(w << 16); }
__device__ __forceinline__ float bf_hi(unsigned w) { return __uint_as_float(w & 0xffff0000u); }
__device__ __forceinline__ float sigmoid_f(float x) { return __builtin_amdgcn_rcpf(1.0f + __builtin_amdgcn_exp2f(-LOG2E * x)); }
__device__ __forceinline__ float gelu_tanh(float x) { const float u = 1.5957691216057308f * (x + 0.044715f * x * x * x); return x * sigmoid_f(u); }
__device__ __forceinline__ float rinv16(const float* ssq, int row, float inv_n) {
    const f32x4* p = (const f32x4*)(ssq + (size_t)row * 16);
    const f32x4 a = p[0], b = p[1], c = p[2], d = p[3];
    const float s = ((a[0] + a[1]) + (a[2] + a[3])) + ((b[0] + b[1]) + (b[2] + b[3])) + ((c[0] + c[1]) + (c[2] + c[3])) + ((d[0] + d[1]) + (d[2] + d[3]));
    return __builtin_amdgcn_rsqf(s * inv_n + NORM_EPS);
}

struct RtPre { f32x4 a, b, c, d; };
__device__ __forceinline__ RtPre rtpre_load(const float* ssq, int row) { const f32x4* p = (const f32x4*)(ssq + (size_t)row * 16); RtPre r; r.a = p[0]; r.b = p[1]; r.c = p[2]; r.d = p[3]; return r; }
__device__ __forceinline__ float rtpre_rinv(const RtPre& p, float inv_n) {
    const float s = ((p.a[0] + p.a[1]) + (p.a[2] + p.a[3])) + ((p.b[0] + p.b[1]) + (p.b[2] + p.b[3])) + ((p.c[0] + p.c[1]) + (p.c[2] + p.c[3])) + ((p.d[0] + p.d[1]) + (p.d[2] + p.d[3]));
    return __builtin_amdgcn_rsqf(s * inv_n + NORM_EPS); }
template <class Sched> __device__ __forceinline__ void rtab_hook(const Sched& S, const Unit& u0, const RtPre& pre, const float* ssq, PG8_LAS float* rt) {
    int t_ = threadIdx.x; asm volatile("" : "+v"(t_));
    if (t_ < 256) { const float r0 = rtpre_rinv(pre, 1.0f / 1024.0f); Unit u_;
        for (int i_ = 0; i_ < 8 && S.next(i_, u_); ++i_) { float r = r0; if (u_.pm != u0.pm) r = rinv16(ssq, u_.pm * 256 + t_, 1.0f / 1024.0f); rt[i_ * 256 + t_] = r; } }
}
template <int MODE> struct EpiAct {
    static constexpr bool PERM = true, AFTER_DRAIN = false, MIDSCALE = false, PREHOOK = (MODE == 0 || MODE == 1);
    bf16_t* O; int ldo; size_t seg_stride; int us_rows; const float* ssq; float* st; const bf16_t* aux; const float* bias; const PG8_LAS float* rtab;
    bf16_t* Ox = nullptr; int ldox = 0; int xrow0 = 0; RtPre pre = {};
    template <class Sched> __device__ __forceinline__ void prehook(const Sched& S, const Unit& u0) const { rtab_hook(S, u0, pre, ssq, (PG8_LAS float*)rtab); }
    __device__ __forceinline__ void xrows(const f32x4 (&ax)[2], const Unit& u, int wr, int wc, int fr, int fq) const {
        static_assert(MODE == 1 || MODE == 3, "extra rows: w_up and plain epilogues only");
        int upm = u.pm, upn = u.pn; asm volatile("" : "+s"(upm), "+s"(upn));
        const int xr = (upm >> 1) * 16 + fr, c0 = upn * BM + wr * HALF + wc * 32 + 8 * fq;
        f32x4 v0 = ax[0], v1 = ax[1];
        if (MODE == 1) { const float r = rinv16(ssq, xrow0 + xr, 1.0f / 1024.0f);
#pragma unroll
            for (int j = 0; j < 4; ++j) { const float a = fmaxf(v0[j] * r, 0.f), b = fmaxf(v1[j] * r, 0.f); v0[j] = a * a; v1[j] = b * b; } }
        u32x4 w; w.x = cvt_pk_bf16(v0[0], v0[1]); w.y = cvt_pk_bf16(v0[2], v0[3]); w.z = cvt_pk_bf16(v1[0], v1[1]); w.w = cvt_pk_bf16(v1[2], v1[3]);
        store16_wt(Ox + (size_t)xr * ldox + c0, w);
    }
    __device__ __forceinline__ void operator()(const f32x4 (&acc)[2][2][4][2], const Unit& u, int wr, int wc, int fr, int fq) const {
        int upm = u.pm, upn = u.pn; asm volatile("" : "+s"(upm), "+s"(upn));
        const int row0 = upm * BM + wr * 64 + fr;
        int seg = 0; bf16_t* base = O; int colt = upn * BM;
        if (MODE == 0) { seg = upn >> 1; base = O + (size_t)seg * seg_stride; colt = (upn & 1) * BM; }
        if (MODE == 1) { base = O + ((size_t)(upm * us_rows + upn) << 16) - (size_t)(upm * BM) * ldo; colt = 0; }
        const int col0 = colt + wc * 32 + 8 * fq;
        f32x4 bv[2][2];
#pragma unroll
        for (int bj = 0; bj < 2; ++bj)
#pragma unroll
            for (int n = 0; n < 2; ++n) bv[bj][n] = (MODE == 2) ? *(const f32x4*)(bias + col0 + bj * HALF + 4 * n) : (f32x4){0.f, 0.f, 0.f, 0.f};
        float rr[2][4];
#pragma unroll
        for (int ai = 0; ai < 2; ++ai)
#pragma unroll
            for (int m = 0; m < 4; ++m) { rr[ai][m] = 1.f; if (MODE == 0 || MODE == 1) rr[ai][m] = (u.ui < 8) ? rtab[u.ui * 256 + wr * 64 + fr + ai * HALF + m * 16] : rinv16(ssq, row0 + ai * HALF + m * 16, 1.0f / 1024.0f); }
        u32x4 yq[2][2];
        if (MODE == 2) {
#pragma unroll
            for (int bj = 0; bj < 2; ++bj) yq[0][bj] = *(const u32x4*)(aux + (size_t)row0 * 512 + col0 + bj * HALF); }
#pragma unroll
        for (int ai = 0; ai < 2; ++ai)
#pragma unroll
            for (int m = 0; m < 4; ++m) {
                const int row = row0 + ai * HALF + m * 16;
                const float r = rr[ai][m];
                float s1 = 0.f, s2 = 0.f;
                if (MODE == 2) { if (ai * 4 + m < 7) { const int gn = ai * 4 + m + 1, rown = row0 + (gn >> 2) * HALF + (gn & 3) * 16;
#pragma unroll
                    for (int bj = 0; bj < 2; ++bj) yq[gn & 1][bj] = *(const u32x4*)(aux + (size_t)rown * 512 + col0 + bj * HALF); } }
#pragma unroll
                for (int bj = 0; bj < 2; ++bj) {
                    f32x4 v0 = acc[ai][bj][m][0] * r, v1 = acc[ai][bj][m][1] * r;
                    if (MODE == 0) { if (seg != 0) {
#pragma unroll
                        for (int j = 0; j < 4; ++j) { v0[j] = gelu_tanh(v0[j]); v1[j] = gelu_tanh(v1[j]); } }
                        if (seg == 2) {
#pragma unroll
                            for (int j = 0; j < 4; ++j) { s1 += v0[j] + v1[j]; s2 += v0[j] * v0[j] + v1[j] * v1[j]; } } }
                    if (MODE == 1) {
#pragma unroll
                        for (int j = 0; j < 4; ++j) { const float a = fmaxf(v0[j], 0.f), b = fmaxf(v1[j], 0.f); v0[j] = a * a; v1[j] = b * b; } }
                    if (MODE == 2) {
                        const u32x4 yv = yq[(ai * 4 + m) & 1][bj];
                        const f32x4 b0 = bv[bj][0], b1 = bv[bj][1];
                        v0[0] = bf_lo(yv.x) * sigmoid_f(v0[0] + b0[0]); v0[1] = bf_hi(yv.x) * sigmoid_f(v0[1] + b0[1]);
                        v0[2] = bf_lo(yv.y) * sigmoid_f(v0[2] + b0[2]); v0[3] = bf_hi(yv.y) * sigmoid_f(v0[3] + b0[3]);
                        v1[0] = bf_lo(yv.z) * sigmoid_f(v1[0] + b1[0]); v1[1] = bf_hi(yv.z) * sigmoid_f(v1[1] + b1[1]);
                        v1[2] = bf_lo(yv.w) * sigmoid_f(v1[2] + b1[2]); v1[3] = bf_hi(yv.w) * sigmoid_f(v1[3] + b1[3]);
#pragma unroll
                        for (int j = 0; j < 4; ++j) s2 += v0[j] * v0[j] + v1[j] * v1[j];
                    }
                    u32x4 w; w.x = cvt_pk_bf16(v0[0], v0[1]); w.y = cvt_pk_bf16(v0[2], v0[3]); w.z = cvt_pk_bf16(v1[0], v1[1]); w.w = cvt_pk_bf16(v1[2], v1[3]);
                    if (MODE == 0 && seg == 0) { const int c = col0 + bj * HALF;
                        store16_wt(base + ((size_t)(c >> 4) * us_rows + row) * 16 + (c & 8), w); }
                    else store16_wt(base + (size_t)row * ldo + col0 + bj * HALF, w);
                }
                if (MODE == 0) { if (seg == 2) {
                    s1 += fshx<16>(s1); s1 += fshx<32>(s1); s2 += fshx<16>(s2); s2 += fshx<32>(s2);
                    if (fq == 0) { f32x2 o; o.x = s1; o.y = s2; *(f32x2*)(st + (size_t)row * 16 + ((upn & 1) * 4 + wc) * 2) = o; } } }
                if (MODE == 2) { s2 += fshx<16>(s2); s2 += fshx<32>(s2); if (fq == 0) st[(size_t)row * 8 + upn * 4 + wc] = s2; }
                asm volatile("" ::: "memory");
            }
    }
};

template <bool GATED, bool MID = false> struct EpiRes {
    static constexpr bool PREHOOK = GATED || MID;
    static constexpr bool PERM = true, AFTER_DRAIN = false, MIDSCALE = MID;
    __device__ __forceinline__ void midscale(f32x4 (&acc)[2][2][4][2], const Unit& u, int wr, int fr) const {
#pragma unroll
        for (int ai = 0; ai < 2; ++ai)
#pragma unroll
            for (int m = 0; m < 4; ++m) { const float s = rtab[u.ui * 512 + 256 + wr * 64 + fr + ai * HALF + m * 16];
#pragma unroll
                for (int bj = 0; bj < 2; ++bj)
#pragma unroll
                    for (int n = 0; n < 2; ++n) acc[ai][bj][m][n] = acc[ai][bj][m][n] * s; }
    }
    const bf16_t* hin; bf16_t* hb; float* ssq_out; const float* ssq_in; const bf16_t* pl; int dry; const PG8_LAS float* rtab; RtPre pre = {}; const float* gs = nullptr; const float* gq = nullptr; int gq_stride = 0; int xrow0 = 0; PG8_LAS float* xs = nullptr;
    __device__ __forceinline__ void xrows(const f32x4 (&ax)[2], const Unit& u, int wr, int wc, int fr_, int fq_) const {
        int upm = u.pm, upn = u.pn; asm volatile("" : "+s"(upm), "+s"(upn));
        int fr = fr_, fq = fq_; asm volatile("" : "+v"(fr), "+v"(fq));
        const int row = xrow0 + (upm >> 1) * 16 + fr; const size_t off = (size_t)row * 1024 + upn * BM + wr * HALF + wc * 32 + 8 * fq;
        const u32x4 hq = *(const u32x4*)(hin + off);
        f32x4 a0 = ax[0], a1 = ax[1];
        if (GATED) { const float r = rinv16(ssq_in, row, 1.0f / 1024.0f); const u32x4 p4 = *(const u32x4*)(pl + off);
            a0[0] = sigmoid_f(a0[0] * r) * bf_lo(p4.x); a0[1] = sigmoid_f(a0[1] * r) * bf_hi(p4.x); a0[2] = sigmoid_f(a0[2] * r) * bf_lo(p4.y); a0[3] = sigmoid_f(a0[3] * r) * bf_hi(p4.y);
            a1[0] = sigmoid_f(a1[0] * r) * bf_lo(p4.z); a1[1] = sigmoid_f(a1[1] * r) * bf_hi(p4.z); a1[2] = sigmoid_f(a1[2] * r) * bf_lo(p4.w); a1[3] = sigmoid_f(a1[3] * r) * bf_hi(p4.w); }
        const f32x4 x0 = (f32x4){bf_lo(hq.x), bf_hi(hq.x), bf_lo(hq.y), bf_hi(hq.y)} + a0, x1 = (f32x4){bf_lo(hq.z), bf_hi(hq.z), bf_lo(hq.w), bf_hi(hq.w)} + a1;
        u32x4 w; w.x = cvt_pk_bf16(x0[0], x0[1]); w.y = cvt_pk_bf16(x0[2], x0[3]); w.z = cvt_pk_bf16(x1[0], x1[1]); w.w = cvt_pk_bf16(x1[2], x1[3]);
        *(u32x4*)(hb + off) = w;
        float sq = ((x0[0] * x0[0] + x0[1] * x0[1]) + (x0[2] * x0[2] + x0[3] * x0[3])) + ((x1[0] * x1[0] + x1[1] * x1[1]) + (x1[2] * x1[2] + x1[3] * x1[3]));
        sq += fshx<16>(sq); sq += fshx<32>(sq);
        if (fq == 0) xs[wr * 64 + wc * 16 + fr] = sq;
        __syncthreads();
        if (wr == 0 && fq == 0) ssq_out[(size_t)row * 16 + upn * 4 + wc] = xs[wc * 16 + fr] + xs[64 + wc * 16 + fr];
        __syncthreads();
    }
    template <class Sched> __device__ __forceinline__ void prehook(const Sched& S, const Unit& u0) const {
        if constexpr (!MID) rtab_hook(S, u0, pre, ssq_in, (PG8_LAS float*)rtab);
        else { int t_ = threadIdx.x; asm volatile("" : "+v"(t_)); PG8_LAS float* rt = (PG8_LAS float*)rtab;
            if (t_ < 256) { Unit u_;
                for (int i_ = 0; i_ < 4 && S.next(i_, u_); ++i_) { f32x4 a = pre.a, b = pre.b; float q0 = pre.c[0], q1 = pre.c[1];
                    if (u_.pm != u0.pm) { const size_t row = (size_t)u_.pm * 256 + t_; a = *(const f32x4*)(gs + row * 8); b = *(const f32x4*)(gs + row * 8 + 4); q0 = gq[row]; q1 = gq[gq_stride + row]; }
                    const float rs = __builtin_amdgcn_rsqf((((a[0] + a[1]) + (a[2] + a[3])) + ((b[0] + b[1]) + (b[2] + b[3]))) * (1.0f / 512.0f) + NORM_EPS), rg = __builtin_amdgcn_rsqf((q0 + q1) * (1.0f / 512.0f) + NORM_EPS);
                    rt[i_ * 512 + t_] = rg; rt[i_ * 512 + 256 + t_] = rs * __builtin_amdgcn_rcpf(rg); } } }
    }
    __device__ __forceinline__ void operator()(const f32x4 (&acc)[2][2][4][2], const Unit& u, int wr, int wc, int fr, int fq) const {
        int upm = u.pm, upn = u.pn; asm volatile("" : "+s"(upm), "+s"(upn));
        const int row0 = upm * BM + wr * 64 + fr, col0 = upn * BM + wc * 32 + 8 * fq;
        constexpr int NPF = 2;
#pragma unroll
        for (int ai = 0; ai < 2; ++ai)
#pragma unroll
            for (int mp = 0; mp < 4 / NPF; ++mp) {
                u32x4 hv[NPF][2]; u32x4 pv[NPF][2];
#pragma unroll
                for (int mm = 0; mm < NPF; ++mm) { const int row = row0 + ai * HALF + (NPF * mp + mm) * 16;
#pragma unroll
                    for (int bj = 0; bj < 2; ++bj) { const size_t off = (size_t)row * 1024 + col0 + bj * HALF; hv[mm][bj] = *(const u32x4*)(hin + off); if (GATED) pv[mm][bj] = *(const u32x4*)(pl + off); } }
#pragma unroll
                for (int mm = 0; mm < NPF; ++mm) { const int m = NPF * mp + mm, row = row0 + ai * HALF + m * 16;
                    float r = 1.f; if (GATED) r = (u.ui < 8) ? rtab[u.ui * 256 + wr * 64 + fr + ai * HALF + m * 16] : rinv16(ssq_in, row, 1.0f / 1024.0f);
                    if (MID) r = rtab[u.ui * 512 + wr * 64 + fr + ai * HALF + m * 16];
                    float sq = 0.f;
#pragma unroll
                    for (int bj = 0; bj < 2; ++bj) { const size_t off = (size_t)row * 1024 + col0 + bj * HALF;
                        f32x4 a0 = acc[ai][bj][m][0], a1 = acc[ai][bj][m][1]; const u32x4 hq = hv[mm][bj];
                        f32x4 x0 = (f32x4){bf_lo(hq.x), bf_hi(hq.x), bf_lo(hq.y), bf_hi(hq.y)}, x1 = (f32x4){bf_lo(hq.z), bf_hi(hq.z), bf_lo(hq.w), bf_hi(hq.w)};
                        if (MID) { a0 = a0 * r; a1 = a1 * r; }
                        if (GATED) { const u32x4 p4 = pv[mm][bj];
                            a0[0] = sigmoid_f(a0[0] * r) * bf_lo(p4.x); a0[1] = sigmoid_f(a0[1] * r) * bf_hi(p4.x); a0[2] = sigmoid_f(a0[2] * r) * bf_lo(p4.y); a0[3] = sigmoid_f(a0[3] * r) * bf_hi(p4.y);
                            a1[0] = sigmoid_f(a1[0] * r) * bf_lo(p4.z); a1[1] = sigmoid_f(a1[1] * r) * bf_hi(p4.z); a1[2] = sigmoid_f(a1[2] * r) * bf_lo(p4.w); a1[3] = sigmoid_f(a1[3] * r) * bf_hi(p4.w); }
                        x0 = x0 + a0; x1 = x1 + a1;
                        u32x4 w; w.x = cvt_pk_bf16(x0[0], x0[1]); w.y = cvt_pk_bf16(x0[2], x0[3]); w.z = cvt_pk_bf16(x1[0], x1[1]); w.w = cvt_pk_bf16(x1[2], x1[3]);
                        if (!dry) *(u32x4*)(hb + off) = w; else asm volatile("" :: "v"(w.x), "v"(w.y), "v"(w.z), "v"(w.w));
                        sq += ((x0[0] * x0[0] + x0[1] * x0[1]) + (x0[2] * x0[2] + x0[3] * x0[3])) + ((x1[0] * x1[0] + x1[1] * x1[1]) + (x1[2] * x1[2] + x1[3] * x1[3])); }
                    sq += fshx<16>(sq); sq += fshx<32>(sq);
                    if (fq == 0 && !dry) ssq_out[(size_t)row * 16 + upn * 4 + wc] = sq; }
                asm volatile("" ::: "memory");
            }
    }
};
struct RevOrder : StaticOrder {
    int nr, rot;
    __device__ __forceinline__ void init_rev(int M, int N, int G_, int c_) { init(M, N, G_, c_); nr = (c < nwg) ? (nwg - c + G - 1) / G : 0; rot = (c >> 3) & 3; if (rot >= nr) rot = 0; }
    __device__ __forceinline__ bool next(int i, Unit& u) const { if (i >= nr) return false; int j = nr - 1 - i + rot; if (j >= nr) j -= nr; const bool ok = StaticOrder::next(j, u); u.ui = i; return ok; }
};
struct PanelOrder {
    int nM, c;
    __device__ __forceinline__ bool next(int i, Unit& u) const { if (c >= nM || i >= 2) return false; u.pm = c; u.pn = i; u.ui = i; return true; }
    __device__ __forceinline__ void a_ready(const Unit&) const {}
    __device__ __forceinline__ void done(const Unit&) const {}
};

template <class Epi, class Sched, bool ALIGN_EPI = false, bool SP2 = false, bool DRAIN = true, bool XR = false>
__device__ __forceinline__ void gemm_phase(PG8_LAS unsigned char* lds, const Gemm g, const Sched& S, const Epi& E) {
    int tid_ = threadIdx.x; asm volatile("" : "+v"(tid_));
    const int tid = tid_, wid = __builtin_amdgcn_readfirstlane(tid >> 6), lane = tid & 63, wr = wid >> 2, wc = wid & 3, fr = lane & 15, fq = lane >> 4;
    const int K = g.K, nt = K / BK, lda = g.lda ? g.lda : K;
    unsigned voffA[2], voffB[2];
#pragma unroll
    for (int i = 0; i < 2; ++i) { int R, C; stage_rc(tid * 16 + i * 8192, R, C); const int Rb = Epi::PERM ? ((R & ~31) + perm32(R & 31)) : R;
        voffA[i] = (unsigned)(R * lda + C) * 2u; voffB[i] = (unsigned)(Rb * K + C) * 2u; }
    const size_t kstep = (size_t)(BK * 2);
    const size_t hstep = (size_t)HALF * K * 2;
    const size_t hstepA = (size_t)HALF * lda * 2;
    const int t0 = g.t0, ntm = nt - 1;
    const size_t kblkA = g.kblk ? (size_t)g.kblk : 4 * kstep;
    const size_t tstep = 2 * hstep;
    const unsigned ldsw = (unsigned)wid * 1024u;
    const int aoff = lds_byte(wr * 64 + fr, fq * 8), boff = lds_byte(wc * 32 + fr, fq * 8);
    static_assert(!XR || SP2, "extra rows: SP2 body only");
    unsigned voffX = 0; const int aoffx = lds_byte(fr, fq * 8);
    if constexpr (XR) { int R, C; stage_rc(wid * 256 + (lane & 15) * 16, R, C); voffX = (unsigned)(R * g.ldax + C) * 2u; }
    const size_t xstep = (size_t)16 * (XR ? g.ldax : 0) * 2;
#define PG8_KOA(x) ((size_t)((((x) + t0) & ntm) >> 2) * kblkA + (size_t)((((x) + t0) & ntm) & 3) * kstep)
#define PG8_KOB(x) ((size_t)(((x) + t0) & ntm) * kstep)
#define PG8_KOX(x) ((size_t)(((x) + t0) & ntm) * kstep)
#define PG8_STAGEX(b, gbase) do { if constexpr (XR) { if (lane < 16) __builtin_amdgcn_global_load_lds((const unsigned*)((const char*)(gbase) + voffX), (PG8_LAS unsigned*)(lds + XR_OFF + (b) * 2048 + wid * 256), 16, 0, 0); } } while (0)
#define PG8_LDX(b) do { if constexpr (XR) { _Pragma("unroll") for (int k = 0; k < 2; ++k) Ax_[k] = *(const PG8_LAS bf16x8*)(lds + XR_OFF + (b) * 2048 + aoffx + k * 1024); } } while (0)
#define PG8_MMAX_(Bt) do { _Pragma("unroll") for (int n = 0; n < 2; ++n) _Pragma("unroll") for (int k = 0; k < 2; ++k) accx[n] = __builtin_amdgcn_mfma_f32_16x16x32_bf16(Bt[n][k], Ax_[k], accx[n], 0, 0, 0); } while (0)
#define PG8_MMAX() do { if constexpr (XR) { if (hasx) { __builtin_amdgcn_s_setprio(1); if (wr == 0) PG8_MMAX_(B0); else PG8_MMAX_(B1); __builtin_amdgcn_s_setprio(0); } } } while (0)
#define PG8_WAIT_LOOP() do { if constexpr (XR) PG8_WAIT_V(9); else PG8_WAIT_V(8); } while (0)
#define PG8_SA(b, h) (((b) * 2 + (h)) * HTB)
#define PG8_SB(b, h) ((4 + (b) * 2 + (h)) * HTB)
#define PG8_STAGE(bufoff, gbase, voff) do { _Pragma("unroll") for (int _i = 0; _i < 2; ++_i) \
        __builtin_amdgcn_global_load_lds((const unsigned*)((const char*)(gbase) + (voff)[_i]), (PG8_LAS unsigned*)(lds + (bufoff) + ldsw + _i * 8192), 16, 0, 0); } while (0)
#define PG8_LDA(dst, b, h) do { _Pragma("unroll") for (int m = 0; m < 4; ++m) _Pragma("unroll") for (int k = 0; k < 2; ++k) dst[m][k] = *(const PG8_LAS bf16x8*)(lds + PG8_SA(b, h) + aoff + m * 2048 + k * 1024); } while (0)
#define PG8_LDB(dst, b, h) do { _Pragma("unroll") for (int n = 0; n < 2; ++n) _Pragma("unroll") for (int k = 0; k < 2; ++k) dst[n][k] = *(const PG8_LAS bf16x8*)(lds + PG8_SB(b, h) + boff + n * 2048 + k * 1024); } while (0)
#define PG8_MMA(ai, bj, At, Bt) do { __builtin_amdgcn_s_setprio(1); _Pragma("unroll") for (int m = 0; m < 4; ++m) _Pragma("unroll") for (int n = 0; n < 2; ++n) _Pragma("unroll") for (int k = 0; k < 2; ++k) \
        acc[ai][bj][m][n] = __builtin_amdgcn_mfma_f32_16x16x32_bf16(Bt[n][k], At[m][k], acc[ai][bj][m][n], 0, 0, 0); __builtin_amdgcn_s_setprio(0); } while (0)
#define PG8_WAIT_V(n) asm volatile("s_waitcnt vmcnt(" #n ")" ::: "memory")
#define PG8_WAIT_L(n) asm volatile("s_waitcnt lgkmcnt(" #n ")" ::: "memory")
#define PG8_BAR __builtin_amdgcn_s_barrier()
#define PG8_SCHED __builtin_amdgcn_sched_barrier(0)
    Unit cur, nxt; int ui = 0;
    if (!S.next(0, cur)) return;
    f32x4 acc[2][2][4][2];
#pragma unroll
    for (int a = 0; a < 2; ++a)
#pragma unroll
        for (int b = 0; b < 2; ++b)
#pragma unroll
            for (int m = 0; m < 4; ++m)
#pragma unroll
                for (int n = 0; n < 2; ++n) acc[a][b][m][n] = (f32x4){0.f, 0.f, 0.f, 0.f};
    bf16x8 At[4][2], B0[2][2], B1[2][2];
    f32x4 accx[2] = {(f32x4){0.f, 0.f, 0.f, 0.f}, (f32x4){0.f, 0.f, 0.f, 0.f}}; bf16x8 Ax_[2]; const int xnh = (g.N / BM) >> 1; bool hasx = XR && (((cur.pm & 1) == 0) == (cur.pn < xnh));
    const char* cX = XR ? (const char*)g.Ax + (size_t)(cur.pm >> 1) * xstep : nullptr;
    const char* cA = (const char*)g.A + (size_t)cur.pm * tstep; const char* cB = (const char*)g.Bt + (size_t)cur.pn * tstep;
    const size_t kx0 = PG8_KOX(0);
    const size_t ka0 = PG8_KOA(0), kb0 = PG8_KOB(0);
    S.a_ready(cur);
    if constexpr (SP2) {
        PG8_STAGE(PG8_SB(0, 0), cB + kb0, voffB); PG8_STAGE(PG8_SB(0, 1), cB + kb0 + hstep, voffB); PG8_STAGE(PG8_SA(0, 0), cA + ka0, voffA); PG8_STAGEX(0, cX + kx0); PG8_STAGE(PG8_SA(0, 1), cA + ka0 + hstepA, voffA);
        if constexpr (Epi::PREHOOK) E.prehook(S, cur);
        if (wr == 1) PG8_BAR;
        PG8_WAIT_V(2); PG8_BAR;
        PG8_STAGE(PG8_SB(1, 0), cB + kb0 + kstep, voffB); PG8_STAGE(PG8_SA(1, 0), cA + ka0 + kstep, voffA); PG8_STAGE(PG8_SB(1, 1), cB + kb0 + hstep + kstep, voffB); PG8_STAGEX(1, cX + kx0 + kstep);
        if constexpr (XR) PG8_WAIT_V(7); else PG8_WAIT_V(6);
        PG8_BAR;
    } else {
        PG8_STAGE(PG8_SB(0, 0), cB + kb0, voffB); PG8_STAGE(PG8_SA(0, 0), cA + ka0, voffA); PG8_STAGE(PG8_SB(0, 1), cB + kb0 + hstep, voffB); PG8_STAGE(PG8_SA(0, 1), cA + ka0 + hstepA, voffA);
        if (wr == 1) PG8_BAR;
        PG8_WAIT_V(4); PG8_BAR;
        PG8_STAGE(PG8_SB(1, 0), cB + kb0 + kstep, voffB); PG8_STAGE(PG8_SA(1, 0), cA + ka0 + kstep, voffA); PG8_STAGE(PG8_SB(1, 1), cB + kb0 + hstep + kstep, voffB);
        PG8_WAIT_V(6); PG8_BAR;
    }
    for (;;) {
        const bool has_next = S.next(ui + 1, nxt);
        const char* nA = has_next ? (const char*)g.A + (size_t)nxt.pm * tstep : cA; const char* nB = has_next ? (const char*)g.Bt + (size_t)nxt.pn * tstep : cB;
        const char* nX = (XR && has_next) ? (const char*)g.Ax + (size_t)(nxt.pm >> 1) * xstep : cX;
        for (int t = 0; t < nt; t += 2) {
            if constexpr (Epi::MIDSCALE) { if (t == (nt >> 1)) E.midscale(acc, cur, wr, fr); }
            const bool last = (t == nt - 2);
            const char* a1 = cA + PG8_KOA(t) + kstep;
            const char* a2 = last ? nA + ka0 : cA + PG8_KOA(t + 2); const char* b2 = last ? nB + kb0 : cB + PG8_KOB(t + 2);
            const char* x2 = XR ? (last ? nX + kx0 : cX + PG8_KOX(t + 2)) : nullptr; const char* x3 = XR ? x2 + kstep : nullptr;
            const char* a3 = a2 + kstep; const char* b3 = b2 + kstep;
            if (last && has_next) S.a_ready(nxt);
            if constexpr (SP2) {
            PG8_LDB(B0, 0, 0); PG8_LDB(B1, 0, 1); PG8_SCHED; PG8_LDA(At, 0, 0); PG8_LDX(0); PG8_STAGE(PG8_SA(1, 1), a1 + hstepA, voffA);
            PG8_WAIT_LOOP(); PG8_WAIT_L(0); PG8_BAR; PG8_MMA(0, 0, At, B0); PG8_MMA(0, 1, At, B1); PG8_MMAX(); PG8_BAR; PG8_SCHED;
            PG8_LDA(At, 0, 1); PG8_STAGE(PG8_SB(0, 0), b2, voffB); PG8_STAGE(PG8_SB(0, 1), b2 + hstep, voffB); PG8_STAGE(PG8_SA(0, 0), a2, voffA); PG8_STAGEX(0, x2);
            PG8_WAIT_LOOP(); PG8_WAIT_L(0); PG8_BAR; PG8_MMA(1, 0, At, B0); PG8_MMA(1, 1, At, B1); PG8_BAR; PG8_SCHED;
            PG8_LDB(B0, 1, 0); PG8_LDB(B1, 1, 1); PG8_SCHED; PG8_LDA(At, 1, 0); PG8_LDX(1); PG8_STAGE(PG8_SA(0, 1), a2 + hstepA, voffA);
            PG8_WAIT_LOOP(); PG8_WAIT_L(0); PG8_BAR; PG8_MMA(0, 0, At, B0); PG8_MMA(0, 1, At, B1); PG8_MMAX(); PG8_BAR; PG8_SCHED;
            PG8_LDA(At, 1, 1); PG8_STAGE(PG8_SB(1, 0), b3, voffB); PG8_STAGE(PG8_SB(1, 1), b3 + hstep, voffB); PG8_STAGE(PG8_SA(1, 0), a3, voffA); PG8_STAGEX(1, x3);
            PG8_WAIT_LOOP(); PG8_WAIT_L(0); PG8_BAR; PG8_MMA(1, 0, At, B0); PG8_MMA(1, 1, At, B1); PG8_BAR; PG8_SCHED;
            } else {
            PG8_LDB(B0, 0, 0); PG8_SCHED; PG8_LDA(At, 0, 0); PG8_STAGE(PG8_SA(1, 1), a1 + hstepA, voffA);
            PG8_WAIT_L(8); PG8_BAR; PG8_WAIT_L(0); PG8_MMA(0, 0, At, B0); PG8_BAR; PG8_SCHED;
            PG8_LDB(B1, 0, 1); PG8_STAGE(PG8_SB(0, 0), b2, voffB);
            PG8_BAR; PG8_WAIT_L(0); PG8_MMA(0, 1, At, B1); PG8_BAR;
            PG8_LDA(At, 0, 1); PG8_STAGE(PG8_SA(0, 0), a2, voffA);
            PG8_BAR; PG8_WAIT_L(0); PG8_MMA(1, 0, At, B0); PG8_BAR; PG8_SCHED;
            PG8_STAGE(PG8_SB(0, 1), b2 + hstep, voffB);
            PG8_WAIT_V(6); PG8_BAR; PG8_MMA(1, 1, At, B1); PG8_BAR;
            PG8_LDB(B0, 1, 0); PG8_SCHED; PG8_LDA(At, 1, 0); PG8_STAGE(PG8_SA(0, 1), a2 + hstepA, voffA);
            PG8_WAIT_L(8); PG8_BAR; PG8_WAIT_L(0); PG8_MMA(0, 0, At, B0); PG8_BAR; PG8_SCHED;
            PG8_LDB(B1, 1, 1); PG8_STAGE(PG8_SB(1, 0), b3, voffB);
            PG8_BAR; PG8_WAIT_L(0); PG8_MMA(0, 1, At, B1); PG8_BAR;
            PG8_LDA(At, 1, 1); PG8_STAGE(PG8_SA(1, 0), a3, voffA);
            PG8_BAR; PG8_WAIT_L(0); PG8_MMA(1, 0, At, B0); PG8_BAR; PG8_SCHED;
            PG8_STAGE(PG8_SB(1, 1), b3 + hstep, voffB);
            PG8_WAIT_V(6); PG8_BAR; PG8_MMA(1, 1, At, B1); PG8_BAR;
            }
        }
        if constexpr (ALIGN_EPI) { if (wr == 0) PG8_BAR; }
        if constexpr (!Epi::AFTER_DRAIN) { E(acc, cur, wr, wc, fr, fq); if constexpr (XR) { if (hasx) E.xrows(accx, cur, wr, wc, fr, fq); } S.done(cur); }
        if (!has_next) break;
#pragma unroll
        for (int a = 0; a < 2; ++a)
#pragma unroll
            for (int b = 0; b < 2; ++b)
#pragma unroll
                for (int m = 0; m < 4; ++m)
#pragma unroll
                    for (int n = 0; n < 2; ++n) acc[a][b][m][n] = (f32x4){0.f, 0.f, 0.f, 0.f};
        cur = nxt; cA = nA; cB = nB; ++ui;
        if constexpr (XR) { cX = nX; hasx = (((cur.pm & 1) == 0) == (cur.pn < xnh)); accx[0] = (f32x4){0.f, 0.f, 0.f, 0.f}; accx[1] = (f32x4){0.f, 0.f, 0.f, 0.f}; }
        if constexpr (ALIGN_EPI) { if (wr == 1) PG8_BAR; }
    }
    if constexpr (DRAIN) PG8_WAIT_V(0);
    if constexpr (!ALIGN_EPI) { if (wr == 0) PG8_BAR; }
    if constexpr (DRAIN) PG8_BAR;
    if constexpr (Epi::AFTER_DRAIN) { E.fused(acc, cur, wr, wc, fr, fq, lds, wid, lane); S.done(cur); }
#undef PG8_KOA
#undef PG8_KOX
#undef PG8_STAGEX
#undef PG8_LDX
#undef PG8_MMAX_
#undef PG8_MMAX
#undef PG8_WAIT_LOOP
#undef PG8_KOB
#undef PG8_SA
#undef PG8_SB
#undef PG8_STAGE
#undef PG8_LDA
#undef PG8_LDB
#undef PG8_MMA
#undef PG8_WAIT_V
#undef PG8_WAIT_L
#undef PG8_BAR
#undef PG8_SCHED
}
}

#ifndef PHMASK
#define PHMASK 0x1ff
#endif
#define PHON(k) (((PHMASK) >> (k)) & 1)
#ifndef PG8_SP2
#define PG8_SP2 true
#endif
#ifndef PG8_ALIGN
#define PG8_ALIGN true
#endif

constexpr int NWAVES = 8;
constexpr int NPH = 16;
#ifndef MK_N_LAUNCHES
#define MK_N_LAUNCHES 1
#endif
constexpr int N_LAUNCHES = MK_N_LAUNCHES;

constexpr int DM = 1024, NBATCH = 8, SEQ = 2048, DEPTH = 2, DECB = 128, DECS = 4;
constexpr int MP = NBATCH * SEQ, MS = DECB * DECS, M = MP + MS;
constexpr int SSMW = 512, GMW = 512, NG = 32, GC = 16, NP = 64, CHUNK = 128, NH = 4, HDIM = 128, PLE = 256, FF = 4096, INW = 1536;
enum In { I_XP = 0, I_XS, I_STRE, I_STIM, I_PP, I_PS, I_GMIX, I_WIN, I_LRE, I_LIM, I_LDT, I_BRE, I_BIM, I_CRE, I_CIM, I_DSK, I_WGLU, I_BGLU, I_GV, I_BV, I_WS, I_BS,
          I_GOS, I_GOG, I_WOUT, I_GFFN, I_WUP, I_WDN, I_GPLE, I_WPG, I_WPLE, I_GFIN, N_IN };
constexpr size_t O_Y = 0, O_REP = (size_t)M * DM, O_IMP = O_REP + 32768, O_RES = O_IMP + 32768, O_IMS = O_RES + 524288, O_VS = O_IMS + 524288, O_END = O_VS + 524288;

constexpr size_t MiB = 1u << 20, KiB = 1u << 10;
constexpr size_t WS_CTL = 0, CTL_ZERO_BYTES = 1 * MiB;
constexpr size_t WS_W = 1 * MiB, W_LAYER = 24 * MiB;
constexpr size_t WO_IN = 0, WO_GLU = 3 * MiB, WO_OUT = 3 * MiB + 512 * KiB, WO_UP = 5 * MiB + 512 * KiB, WO_DN = 13 * MiB + 512 * KiB, WO_PG = 21 * MiB + 512 * KiB, WO_PLE = 23 * MiB + 512 * KiB;
constexpr size_t WS_HB = 49 * MiB;
constexpr size_t WS_PL = 82 * MiB;
constexpr size_t WS_SSQ0 = 115 * MiB, WS_SSQ1 = WS_SSQ0 + 1088 * KiB;
constexpr size_t WS_VST = WS_SSQ1 + 1088 * KiB;
constexpr size_t WS_GS = WS_VST + 1088 * KiB;
constexpr size_t WS_TB = WS_GS + 512 * KiB;
constexpr size_t WS_WSM = WS_TB + 576 * KiB;
constexpr size_t WS_LPOW = WS_WSM + 256 * KiB;
constexpr size_t WS_GQ = WS_LPOW + 1088 * KiB;
constexpr size_t WS_WSUM = WS_GQ + 128 * KiB;
constexpr size_t WS_OVL = 122 * MiB;
constexpr size_t OV_US = 0, OV_UG = 16 * MiB + 512 * KiB, OV_VG = 33 * MiB, OV_YS = 49 * MiB + 512 * KiB, OV_YCAT = 66 * MiB, OV_PB = 99 * MiB;
constexpr size_t OV_FT = 108 * MiB, OV_WT = 109 * MiB, OV_GT = 113 * MiB;
constexpr size_t WS_END = WS_OVL + 132 * MiB;
static_assert(WS_WSUM + 4 * KiB <= WS_OVL && OV_GT + 4 * MiB <= 132 * MiB && WS_END <= 256 * MiB && OV_PB + (size_t)M * PLE * 2 <= 132 * MiB && (size_t)M * FF * 2 <= 132 * MiB, "d_ws map");
constexpr int S5T = 32, S5NC = SEQ / S5T;
constexpr int TB_LAYER = 4096 + 2 * 32768;
constexpr int CW_BAR = 4096;

constexpr int RING_BYTES = 131072, LDSCTL_OFF = RING_BYTES, MISC_OFF = LDSCTL_OFF + 320, RT_OFF = LDSCTL_OFF + 1024, LDS_BYTES = 147456;
static_assert(RT_OFF + 8192 <= LDS_BYTES, "LDS map");
static_assert(pg8::XR_OFF == RT_OFF + 8192 && pg8::XR_OFF + 4096 <= LDS_BYTES && pg8::STAGE_BYTES == RING_BYTES, "LDS map: extra-row strip slots");

#define GAS __attribute__((address_space(1)))
#define LAS __attribute__((address_space(3)))
typedef unsigned short bf16;
typedef unsigned v4u __attribute__((ext_vector_type(4)));
typedef unsigned v2u __attribute__((ext_vector_type(2)));
typedef float f32x4 __attribute__((ext_vector_type(4)));
typedef float f32x2 __attribute__((ext_vector_type(2)));
typedef short bf16x8 __attribute__((ext_vector_type(8)));
typedef GAS unsigned gu32;
#define RLX_AGENT __ATOMIC_RELAXED, __HIP_MEMORY_SCOPE_AGENT
#define LDS_WAIT() asm volatile("s_waitcnt lgkmcnt(0)" ::: "memory")
#define VM_WAIT() asm volatile("s_waitcnt vmcnt(0)" ::: "memory")
__device__ __forceinline__ unsigned f2bf(float f) { unsigned u = __builtin_bit_cast(unsigned, f); return (u + 0x7fffu + ((u >> 16) & 1u)) >> 16; }
__device__ __forceinline__ unsigned pk2(float lo, float hi) { unsigned r; asm("v_cvt_pk_bf16_f32 %0, %1, %2" : "=v"(r) : "v"(lo), "v"(hi)); return r; }
__device__ __forceinline__ float bflo(unsigned w) { return __uint_as_float(w << 16); }
__device__ __forceinline__ float bfhi(unsigned w) { return __uint_as_float(w & 0xffff0000u); }
__device__ __forceinline__ float bf1(bf16 h) { return __uint_as_float((unsigned)h << 16); }
using pg8::sigmoid_f; using pg8::gelu_tanh; using pg8::rinv16; using pg8::NORM_EPS;

#define XB_TMO      128
#define XB_XCNT(j)  (256  + 64 * (j))
#define XB_XSUB(j)  (1280 + 64 * (j))
#define XB_XGEN(j)  (2304 + 64 * (j))
#define XB_TOP      3328
#define XB_TOPGEN   3392
#define XCD_BAR_WORDS 3456
#define XB_SPIN_CAP (1u << 18)

__device__ __forceinline__ unsigned xb_ld(unsigned* p)              { return __hip_atomic_load(p, __ATOMIC_RELAXED, __HIP_MEMORY_SCOPE_AGENT); }
__device__ __forceinline__ unsigned xb_add(unsigned* p, unsigned v) { return __hip_atomic_fetch_add(p, v, __ATOMIC_RELAXED, __HIP_MEMORY_SCOPE_AGENT); }
__device__ __forceinline__ unsigned xb_xcc_id() { return (unsigned)__builtin_amdgcn_s_getreg((3 << 11) | 20) & 0xFu; }
#define XB_SPIN(cond, bar) do { unsigned _sp = 0; while (cond) { __builtin_amdgcn_s_sleep(1); \
    if ((++_sp & 255u) == 0u) { if (xb_ld(&(bar)[XB_TMO])) break; if (_sp > XB_SPIN_CAP) { atomicAdd(&(bar)[XB_TMO], 1u); break; } } } } while (0)

struct XcdBarrier {
    unsigned* bar; unsigned x;
    volatile LAS unsigned* st;
};

__device__ __forceinline__ XcdBarrier xcd_barrier_post(unsigned* bar, volatile LAS unsigned* st) {
    XcdBarrier b; b.bar = bar; b.x = xb_xcc_id(); b.st = st;
    if (threadIdx.x == 0) (void)xb_add(&bar[XB_XCNT(b.x)], 1u);
    return b;
}
__device__ __forceinline__ void xcd_barrier_complete(unsigned* bar, unsigned x, unsigned& nloc, unsigned& nx, unsigned& mask) {
    const unsigned G = gridDim.x * gridDim.y * gridDim.z;
    unsigned sum, cnt, mine, msk, sp = 0u;
    for (;;) {
        sum = 0u; cnt = 0u; mine = 0u; msk = 0u;
#pragma unroll
        for (unsigned j = 0; j < 16; ++j) { const unsigned c = xb_ld(&bar[XB_XCNT(j)]); sum += c; cnt += (c > 0u) ? 1u : 0u; msk |= (c > 0u) ? (1u << j) : 0u; mine = (j == x) ? c : mine; }
        if (sum == G) break;
        __builtin_amdgcn_s_sleep(1);
        if ((++sp & 255u) == 0u) { if (xb_ld(&bar[XB_TMO])) break; if (sp > XB_SPIN_CAP) { atomicAdd(&bar[XB_TMO], 1u); break; } }
    }
    nloc = mine > 0u ? mine : 1u; nx = cnt > 0u ? cnt : 1u; mask = msk ? msk : (1u << x);
}

__device__ __forceinline__ void xcd_barrier(const XcdBarrier& b) {
    asm volatile("s_waitcnt vmcnt(0)" ::: "memory");
    __syncthreads();
    if (threadIdx.x == 0) {
        unsigned* bar = b.bar; unsigned bx_ = b.x; asm volatile("" : "+s"(bar), "+s"(bx_));
        __builtin_amdgcn_s_waitcnt(0);
        unsigned nloc = b.st[0], nx = b.st[1];
        unsigned xmask = b.st[2];
        if (nloc == 0u) { xcd_barrier_complete(bar, bx_, nloc, nx, xmask); b.st[0] = nloc; b.st[1] = nx; b.st[2] = xmask; }
        const unsigned old = xb_add(&bar[XB_XSUB(bx_)], 1u);
        const unsigned gen = old / nloc;
        if (old + 1u == (gen + 1u) * nloc) {
            __builtin_amdgcn_fence(__ATOMIC_RELEASE, "agent");
            asm volatile("s_waitcnt vmcnt(0)" ::: "memory");
#pragma unroll
            for (unsigned j = 0; j < 16; ++j) if ((xmask >> j) & 1u) (void)xb_add(&bar[XB_XGEN(j)], 1u);
        }
        XB_SPIN(xb_ld(&bar[XB_XGEN(bx_)]) < (gen + 1u) * nx, bar);
        __builtin_amdgcn_fence(__ATOMIC_ACQUIRE, "agent");
        asm volatile("s_waitcnt vmcnt(0)" ::: "memory");
    }
    __syncthreads();
}

template <class T> __device__ __forceinline__ T* gptr_(T* p) { unsigned long long v_ = (unsigned long long)p; asm volatile("" : "+s"(v_)); return (T*)(GAS T*)v_; }
#define GPTR(T, p) gptr_<T>(p)
#define GIN(i) GPTR(const float, args.in[i])

__device__ __forceinline__ int opq(int x) { asm volatile("" : "+s"(x)); return x; }
__device__ __forceinline__ float wave_sum(float v) {
    v += fshx<1>(v); v += fshx<2>(v); v += fshx<4>(v); v += fshx<8>(v); v += fshx<16>(v); v += fshx<32>(v);
    return v;
}
__device__ __forceinline__ void dsincos(double x, double& s, double& c) {
    const double k = __builtin_rint(x * 0.63661977236758134308);
    double r = __builtin_fma(-k, 1.57079632679489655800e+00, x);
    r = __builtin_fma(-k, 6.12323399573676603587e-17, r);
    const int q = (int)k & 3;
    const double z = r * r;
    double sp = -1.0 / 1307674368000.0; sp = sp * z + 1.0 / 6227020800.0; sp = sp * z - 1.0 / 39916800.0; sp = sp * z + 1.0 / 362880.0; sp = sp * z - 1.0 / 5040.0; sp = sp * z + 1.0 / 120.0; sp = sp * z - 1.0 / 6.0; sp = sp * z + 1.0; sp = sp * r;
    double cp = -1.0 / 87178291200.0; cp = cp * z + 1.0 / 479001600.0; cp = cp * z - 1.0 / 3628800.0; cp = cp * z + 1.0 / 40320.0; cp = cp * z - 1.0 / 720.0; cp = cp * z + 1.0 / 24.0; cp = cp * z - 0.5; cp = cp * z + 1.0;
    s = (q == 0) ? sp : (q == 1) ? cp : (q == 2) ? -sp : -cp;
    c = (q == 0) ? cp : (q == 1) ? -sp : (q == 2) ? -cp : sp;
}
__device__ __forceinline__ double dexp(double x) {
    const double k = __builtin_rint(x * 1.44269504088896338700e+00);
    double r = __builtin_fma(-k, 6.93147180369123816490e-01, x);
    r = __builtin_fma(-k, 1.90821492927058770002e-10, r);
    double p = 1.0 / 6227020800.0;
    p = p * r + 1.0 / 479001600.0; p = p * r + 1.0 / 39916800.0; p = p * r + 1.0 / 3628800.0; p = p * r + 1.0 / 362880.0; p = p * r + 1.0 / 40320.0; p = p * r + 1.0 / 5040.0;
    p = p * r + 1.0 / 720.0; p = p * r + 1.0 / 120.0; p = p * r + 1.0 / 24.0; p = p * r + 1.0 / 6.0; p = p * r + 0.5; p = p * r + 1.0; p = p * r + 1.0;
    const long long bits = ((long long)((int)k + 1023)) << 52;
    return p * __builtin_bit_cast(double, bits);
}

struct TItem { const float* W; bf16* WT; const float* gs; int K, N, k0, n0; };
__device__ __forceinline__ void p0_t_load(const TItem& t, int lane, f32x4 (&v)[8]) {
#pragma unroll
    for (int i = 0; i < 8; ++i) v[i] = *(const f32x4*)(t.W + (size_t)(t.k0 + 8 * i + (lane >> 3)) * t.N + t.n0 + 4 * (lane & 7));
}
__device__ __forceinline__ void p0_t_finish(const TItem& t, int lane, const f32x4 (&v)[8], LAS float* scr) {
#pragma unroll
    for (int i = 0; i < 8; ++i) { const int kk = 8 * i + (lane >> 3); f32x4 x = v[i]; if (t.gs) x = x * t.gs[t.k0 + kk]; LAS float* d = scr + kk * 33 + 4 * (lane & 7); d[0] = x[0]; d[1] = x[1]; d[2] = x[2]; d[3] = x[3]; }
    LDS_WAIT(); asm volatile("" ::: "memory");
    const int c = lane & 7;
#pragma unroll
    for (int j = 0; j < 4; ++j) { const int n = (lane >> 3) + 8 * j; const LAS float* s = scr + (8 * c) * 33 + n;
        v4u o; o.x = pk2(s[0 * 33], s[1 * 33]); o.y = pk2(s[2 * 33], s[3 * 33]); o.z = pk2(s[4 * 33], s[5 * 33]); o.w = pk2(s[6 * 33], s[7 * 33]);
        *(GAS v4u*)(t.WT + (size_t)(t.n0 + n) * t.K + t.k0 + 8 * c) = o; }
    LDS_WAIT(); asm volatile("" ::: "memory");
}
struct Args { const float* in[N_IN]; float* out; unsigned char* ws; int ph_lo, ph_hi, li, pad; };

constexpr int P0_I_IN = 16 * 48, P0_I_GLU = 8 * 16, P0_I_OUT = 16 * 32, P0_I_UP = 16 * 128, P0_I_DN = 64 * 32, P0_I_PG = 16 * 32, P0_I_PLE = 4 * 32, P0_I_LAYER = P0_I_IN + P0_I_GLU + P0_I_OUT + P0_I_UP + P0_I_DN + P0_I_PG + P0_I_PLE;
__device__ __forceinline__ void p0_convert(const Args& args, LAS unsigned char* lds, int lane, int wave, int gw, int NGW, int it_lo, int it_hi) {
    unsigned char* ws = GPTR(unsigned char, args.ws);
    LAS float* scr = (LAS float*)(lds + wave * 16384);
    constexpr int I_IN = P0_I_IN, I_GLU = P0_I_GLU, I_OUT = P0_I_OUT, I_UP = P0_I_UP, I_DN = P0_I_DN, I_PG = P0_I_PG, I_LAYER = P0_I_LAYER;
    auto item = [&](int it, TItem& t) {
        const int L = it / I_LAYER; int r = it % I_LAYER; unsigned char* wl = ws + WS_W + (size_t)L * W_LAYER; int nblk;
        if (r < I_IN) { t.W = GIN(I_WIN) + (size_t)L * DM * INW; t.K = DM; t.N = INW; t.WT = (bf16*)(wl + WO_IN); t.gs = GIN(I_GMIX) + L * DM; }
        else if ((r -= I_IN) < I_GLU) { t.W = GIN(I_WGLU) + (size_t)L * SSMW * SSMW; t.K = SSMW; t.N = SSMW; t.WT = (bf16*)(wl + WO_GLU); t.gs = nullptr; }
        else if ((r -= I_GLU) < I_OUT) { t.W = GIN(I_WOUT) + (size_t)L * DM * DM; t.K = DM; t.N = DM; t.WT = (bf16*)(wl + WO_OUT); t.gs = (r / 32 < 8) ? GIN(I_GOS) + L * SSMW : GIN(I_GOG) + L * GMW - SSMW; }
        else if ((r -= I_OUT) < I_UP) { t.W = GIN(I_WUP) + (size_t)L * DM * FF; t.K = DM; t.N = FF; t.WT = (bf16*)(wl + WO_UP); t.gs = GIN(I_GFFN) + L * DM; }
        else if ((r -= I_UP) < I_DN) { t.W = GIN(I_WDN) + (size_t)L * FF * DM; t.K = FF; t.N = DM; t.WT = (bf16*)(wl + WO_DN); t.gs = nullptr; }
        else if ((r -= I_DN) < I_PG) { t.W = GIN(I_WPG) + (size_t)L * DM * DM; t.K = DM; t.N = DM; t.WT = (bf16*)(wl + WO_PG); t.gs = GIN(I_GPLE) + L * DM; }
        else { r -= I_PG; t.W = GIN(I_WPLE) + (size_t)L * PLE * DM; t.K = PLE; t.N = DM; t.WT = (bf16*)(wl + WO_PLE); t.gs = nullptr; }
        nblk = t.N / 32; t.k0 = 64 * (r / nblk); t.n0 = 32 * (r % nblk);
    };
    for (int it = it_lo + gw; it < it_hi; it += 2 * NGW) {
        TItem ta, tb2; f32x4 va[8], vb[8]; const bool two = it + NGW < it_hi;
        item(it, ta); p0_t_load(ta, lane, va);
        if (two) { item(it + NGW, tb2); p0_t_load(tb2, lane, vb); }
        p0_t_finish(ta, lane, va, scr);
        if (two) p0_t_finish(tb2, lane, vb, scr);
    }
}
__device__ __forceinline__ void p0_prologue(const Args& args, LAS unsigned char* lds, int tid, int lane, int wave, int bx, int G) {
    unsigned char* ws = GPTR(unsigned char, args.ws);
    const int gw = bx * NWAVES + wave, NGW = G * NWAVES;
    const int gt = bx * (NWAVES * 64) + tid, NGT = G * NWAVES * 64;
    p0_convert(args, lds, lane, wave, gw, NGW, 0, P0_I_IN);
    {
        bf16* hb = (bf16*)(ws + WS_HB); float* ssq = (float*)(ws + WS_SSQ0);
        for (int m0 = gw; m0 < M; m0 += 3 * NGW) {
            f32x4 v[3][4];
#pragma unroll
            for (int q = 0; q < 3; ++q) { const int m = m0 + q * NGW; if (m < M) { const float* src = (m < MP) ? GIN(I_XP) + (size_t)m * DM : GIN(I_XS) + (size_t)(m - MP) * DM;
                const GAS f32x4* xr = (const GAS f32x4*)src + 2 * lane;
#pragma unroll
                for (int j = 0; j < 2; ++j) { v[q][2 * j] = xr[128 * j]; v[q][2 * j + 1] = xr[128 * j + 1]; } } }
#pragma unroll
            for (int q = 0; q < 3; ++q) { const int m = m0 + q * NGW; if (m < M) { GAS v4u* br = (GAS v4u*)(hb + (size_t)m * DM) + lane; float s = 0.f;
#pragma unroll
                for (int j = 0; j < 2; ++j) { const f32x4 x = v[q][2 * j], y = v[q][2 * j + 1]; v4u o; o.x = pk2(x[0], x[1]); o.y = pk2(x[2], x[3]); o.z = pk2(y[0], y[1]); o.w = pk2(y[2], y[3]); br[64 * j] = o;
                    s += ((x[0] * x[0] + x[1] * x[1]) + (x[2] * x[2] + x[3] * x[3])) + ((y[0] * y[0] + y[1] * y[1]) + (y[2] * y[2] + y[3] * y[3])); }
                s = wave_sum(s);
                if (lane < 16) ssq[(size_t)m * 16 + lane] = (lane == 0) ? s : 0.f; } }
        }
    }
    if (gt < DEPTH * NG * NP) {
        const int L = gt >> 11, gp = gt & 2047, g = gp >> 6;
        float* tb = (float*)(ws + WS_TB) + (size_t)L * TB_LAYER;
        double lr = (double)GIN(I_LRE)[L * 2048 + gp]; lr = lr < -1e-4 ? lr : -1e-4;
        const double li = (double)GIN(I_LIM)[L * 2048 + gp];
        const double dt = dexp((double)GIN(I_LDT)[L * NG + g]);
        const double mag = dexp(lr * dt); double sn, cs; dsincos(li * dt, sn, cs);
        const double abr = mag * cs, abi = mag * sn, den = lr * lr + li * li, nr = abr - 1.0, ni = abi;
        const double qr = (nr * lr + ni * li) / den, qi = (ni * lr - nr * li) / den;
        tb[gp] = (float)abr; tb[2048 + gp] = (float)abi;
        const float* bre = GIN(I_BRE) + ((size_t)L * 2048 + gp) * GC; const float* bim = GIN(I_BIM) + ((size_t)L * 2048 + gp) * GC;
#pragma unroll
        for (int h = 0; h < GC; ++h) { const double br = (double)bre[h], bi = (double)bim[h];
            tb[4096 + gp * GC + h] = (float)(qr * br - qi * bi); tb[4096 + 32768 + gp * GC + h] = (float)(qr * bi + qi * br); }
    }
    for (int e = gt; e < DEPTH * NG * NP * (S5T + 1); e += NGT) {
        const int d = e % (S5T + 1), lgp = e / (S5T + 1), p = lgp & 63, lg = lgp >> 6;
        double lr = (double)GIN(I_LRE)[lgp]; lr = lr < -1e-4 ? lr : -1e-4; const double li = (double)GIN(I_LIM)[lgp];
        const double dt = dexp((double)GIN(I_LDT)[lg]);
        const double md = dexp(lr * dt * (double)d); double sd, cd; dsincos(li * dt * (double)d, sd, cd);
        float* lp = (float*)(ws + WS_LPOW) + (((size_t)lg * (S5T + 1) + d) * NP + p) * 2; lp[0] = (float)(md * cd); lp[1] = (float)(md * sd);
    }
    {
        bf16* wsm = (bf16*)(ws + WS_WSM); const float* w_s = GIN(I_WS);
        for (int e = gt; e < DEPTH * NH * CHUNK * CHUNK; e += NGT) { const int s = e & 127, t = (e >> 7) & 127; wsm[e] = (s <= t) ? (bf16)f2bf(w_s[e]) : (bf16)0; }
        float* wsum = (float*)(ws + WS_WSUM);
        for (int e = gw; e < DEPTH * NH * CHUNK; e += NGW) { const int t = e & 127;
            const float a0 = (lane <= t) ? bf1((bf16)f2bf(w_s[(size_t)e * CHUNK + lane])) : 0.f, a1 = (lane + 64 <= t) ? bf1((bf16)f2bf(w_s[(size_t)e * CHUNK + 64 + lane])) : 0.f;
            const float a = wave_sum(a0 + a1); if (lane == 0) wsum[e] = a; }
    }
}

__device__ __forceinline__ void s5_sample_wave(int lane, int b, int g, const float* tb, const float* cre, const float* cim, const float* dsk,
                                               const bf16* US, bf16* YS, const float* st_re, const float* st_im, float* out_re, float* out_im) {
    const int p = lane, gp = g * 64 + p;
    const float ar = tb[gp], ai = tb[2048 + gp];
    float bbr[16], bbi[16], cr[16], ci[16];
#pragma unroll
    for (int q = 0; q < 4; ++q) { const f32x4 a = *(const f32x4*)(tb + 4096 + gp * 16 + 4 * q), c = *(const f32x4*)(tb + 4096 + 32768 + gp * 16 + 4 * q);
#pragma unroll
        for (int j = 0; j < 4; ++j) { bbr[4 * q + j] = a[j]; bbi[4 * q + j] = c[j]; } }
#pragma unroll
    for (int h = 0; h < 16; ++h) { cr[h] = cre[(size_t)(g * 16 + h) * 64 + p]; ci[h] = cim[(size_t)(g * 16 + h) * 64 + p]; }
    float hr = st_re[(size_t)(b * NG + g) * NP + p], hi = st_im[(size_t)(b * NG + g) * NP + p];
    const int ho = ((lane >> 5) & 1) * 8 + ((lane >> 4) & 1) * 4 + ((lane >> 3) & 1) * 2 + ((lane >> 2) & 1);
    const bf16* up0 = US + ((size_t)g * M + MP + (size_t)b * DECS) * 16;
    v4u qa[DECS], qb[DECS]; float uho[DECS];
#pragma unroll
    for (int j = 0; j < DECS; ++j) { qa[j] = *(const v4u*)(up0 + 16 * j); qb[j] = *(const v4u*)(up0 + 16 * j + 8); uho[j] = bf1(up0[16 * j + ho]); }
    const float dkh = dsk[g * 16 + ho];
#pragma unroll
    for (int j = 0; j < DECS; ++j) {
        const size_t row = (size_t)MP + b * DECS + j;
        const v4u q0 = qa[j], q1 = qb[j];
        float u[16];
        u[0] = bflo(q0.x); u[1] = bfhi(q0.x); u[2] = bflo(q0.y); u[3] = bfhi(q0.y); u[4] = bflo(q0.z); u[5] = bfhi(q0.z); u[6] = bflo(q0.w); u[7] = bfhi(q0.w);
        u[8] = bflo(q1.x); u[9] = bfhi(q1.x); u[10] = bflo(q1.y); u[11] = bfhi(q1.y); u[12] = bflo(q1.z); u[13] = bfhi(q1.z); u[14] = bflo(q1.w); u[15] = bfhi(q1.w);
        float br = 0.f, bi = 0.f;
#pragma unroll
        for (int h = 0; h < 16; ++h) { br += bbr[h] * u[h]; bi += bbi[h] * u[h]; }
        const float nr = ar * hr - ai * hi + br, ni = ar * hi + ai * hr + bi; hr = nr; hi = ni;
        float v8[8], v4[4], v2[2], v1;
#pragma unroll
        for (int h = 0; h < 8; ++h) { const float lo = cr[h] * hr - ci[h] * hi, hi8 = cr[h + 8] * hr - ci[h + 8] * hi; const bool up5 = (lane & 32) != 0;
            const float keep = up5 ? hi8 : lo, send = up5 ? lo : hi8; v8[h] = keep + fshx<32>(send); }
#pragma unroll
        for (int h = 0; h < 4; ++h) { const bool b = (lane & 16) != 0; const float keep = b ? v8[h + 4] : v8[h], send = b ? v8[h] : v8[h + 4]; v4[h] = keep + fshx<16>(send); }
#pragma unroll
        for (int h = 0; h < 2; ++h) { const bool b = (lane & 8) != 0; const float keep = b ? v4[h + 2] : v4[h], send = b ? v4[h] : v4[h + 2]; v2[h] = keep + fshx<8>(send); }
        { const bool b = (lane & 4) != 0; const float keep = b ? v2[1] : v2[0], send = b ? v2[0] : v2[1]; v1 = keep + fshx<4>(send); }
        v1 += fshx<2>(v1); v1 += fshx<1>(v1);
        const float yv = v1 + dkh * uho[j];
        if ((lane & 3) == 0) YS[row * SSMW + g * 16 + ho] = (bf16)f2bf(gelu_tanh(yv));
    }
    out_re[(size_t)(b * NG + g) * NP + p] = hr; out_im[(size_t)(b * NG + g) * NP + p] = hi;
}

__device__ __forceinline__ void s5_build_tables(int vt, int NV, const float* tb, const float* lpow, const float* cre, const float* cim, bf16* FT, bf16* WT, bf16* GT) {
    const float* bbr = tb + 4096; const float* bbi = tb + 4096 + 32768;
    const float* abr = tb; const float* abi = tb + 2048;
    for (int e = vt; e < NG * GC * GC * 8; e += NV) {
        const int p8 = e & 7, hi = (e >> 3) & 15, ho = (e >> 7) & 15, g = e >> 11;
        float kd[S5T];
#pragma unroll
        for (int d = 0; d < S5T; ++d) kd[d] = 0.f;
        float ca[8], cb[8], ba[8], bb[8], la[8], lb[8];
#pragma unroll
        for (int q = 0; q < 8; ++q) { const int p = 8 * p8 + q; ca[q] = cre[(size_t)(g * GC + ho) * NP + p]; cb[q] = cim[(size_t)(g * GC + ho) * NP + p];
            ba[q] = bbr[(size_t)(g * NP + p) * GC + hi]; bb[q] = bbi[(size_t)(g * NP + p) * GC + hi]; la[q] = abr[g * NP + p]; lb[q] = abi[g * NP + p]; }
#pragma unroll
        for (int q = 0; q < 8; ++q) { const float lr = la[q], li = lb[q]; float zr = ca[q] * ba[q] - cb[q] * bb[q], zi = ca[q] * bb[q] + cb[q] * ba[q];
#pragma unroll
            for (int d = 0; d < S5T; ++d) { kd[d] += zr; const float nr = zr * lr - zi * li, ni = zr * li + zi * lr; zr = nr; zi = ni; } }
        bf16* fg = FT + (size_t)g * S5T * 512;
#pragma unroll
        for (int d = 0; d < S5T; ++d) { float v = kd[d]; v += fshx<1>(v); v += fshx<2>(v); v += fshx<4>(v);
            if (p8 == (d & 7)) { const bf16 w = (bf16)f2bf(v);
                fg[(size_t)d * 512 + (ho + 16 * (hi >> 3)) * 8 + (hi & 7)] = w;
                if (d + 1 < S5T) fg[(size_t)(d + 1) * 512 + (ho + 16 * (2 + (hi >> 3))) * 8 + (hi & 7)] = w;
                if (d == 0) fg[(ho + 16 * (2 + (hi >> 3))) * 8 + (hi & 7)] = (bf16)0; } }
    }
    for (int e0 = vt; e0 < NG * 8 * 16 * 64; e0 += 4 * NV) {
        f32x2 lq[4]; f32x4 br[4][2], bi[4][2];
#pragma unroll
        for (int u = 0; u < 4; ++u) { const int e = e0 + u * NV; if (e < NG * 8 * 16 * 64) { const int lane = e & 63, ks = (e >> 6) & 15, nb = (e >> 10) & 7, g = e >> 13, fr = lane & 15, fq = lane >> 4;
            const int p = (16 * nb + fr) >> 1, s = 2 * ks + (fq >> 1);
            lq[u] = *(const f32x2*)(lpow + (((size_t)g * (S5T + 1) + (S5T - 1 - s)) * NP + p) * 2);
            const f32x4* b0 = (const f32x4*)(bbr + (size_t)(g * NP + p) * GC + 8 * (fq & 1)); const f32x4* b1 = (const f32x4*)(bbi + (size_t)(g * NP + p) * GC + 8 * (fq & 1));
            br[u][0] = b0[0]; br[u][1] = b0[1]; bi[u][0] = b1[0]; bi[u][1] = b1[1]; } }
#pragma unroll
        for (int u = 0; u < 4; ++u) { const int e = e0 + u * NV; if (e < NG * 8 * 16 * 64) { const bool im = (e & 1) != 0;
            const float lr = lq[u].x, li = lq[u].y; float z[8];
#pragma unroll
            for (int j = 0; j < 8; ++j) { const float b_r = br[u][j >> 2][j & 3], b_i = bi[u][j >> 2][j & 3]; z[j] = im ? (lr * b_i + li * b_r) : (lr * b_r - li * b_i); }
            v4u o; o.x = pk2(z[0], z[1]); o.y = pk2(z[2], z[3]); o.z = pk2(z[4], z[5]); o.w = pk2(z[6], z[7]);
            *(v4u*)(WT + (size_t)e * 8) = o; } }
    }
    for (int e0 = vt; e0 < NG * S5T * 4 * 64; e0 += 4 * NV) {
        f32x4 lp[4][2], cr[4], ci[4];
#pragma unroll
        for (int u = 0; u < 4; ++u) { const int e = e0 + u * NV; if (e < NG * S5T * 4 * 64) { const int lane = e & 63, kk = (e >> 6) & 3, tau = (e >> 8) & 31, g = e >> 13, fr = lane & 15, fq = lane >> 4;
            const int p0 = 16 * kk + 4 * fq;
            const f32x4* l4 = (const f32x4*)(lpow + (((size_t)g * (S5T + 1) + (tau + 1)) * NP + p0) * 2); lp[u][0] = l4[0]; lp[u][1] = l4[1];
            cr[u] = *(const f32x4*)(cre + (size_t)(g * GC + fr) * NP + p0); ci[u] = *(const f32x4*)(cim + (size_t)(g * GC + fr) * NP + p0); } }
#pragma unroll
        for (int u = 0; u < 4; ++u) { const int e = e0 + u * NV; if (e < NG * S5T * 4 * 64) { float z[8];
#pragma unroll
            for (int q = 0; q < 4; ++q) { const float lr = lp[u][q >> 1][2 * (q & 1)], li = lp[u][q >> 1][2 * (q & 1) + 1], a = cr[u][q], b = ci[u][q]; z[2 * q] = a * lr - b * li; z[2 * q + 1] = -(a * li + b * lr); }
            v4u o; o.x = pk2(z[0], z[1]); o.y = pk2(z[2], z[3]); o.z = pk2(z[4], z[5]); o.w = pk2(z[6], z[7]);
            *(v4u*)(GT + (size_t)e * 8) = o; } }
    }
}
__device__ __forceinline__ void s5_prompt_item_mfma(LAS unsigned char* lds, int tid0, int lane0, int wave, int n, int g, const bf16* USg, const bf16* FTg, const bf16* WTg, const bf16* GTg,
                                                    const float* ltp, const float* dsk, bf16* YS, float* out_re, float* out_im) {
    constexpr int U_OFF = 0, R2_OFF = 64 * 1056, HP_OFF = R2_OFF + 64 * 132 * 4;
#define S5_LAUNDER() int tid_ = tid0, lane_ = lane0; asm volatile("" : "+v"(tid_), "+v"(lane_)); const int tid = tid_, lane = lane_, fr = lane & 15, fq = lane >> 4; (void)tid; (void)fr; (void)fq
    { S5_LAUNDER(); const bf16* usrc = USg + ((size_t)g * M + (size_t)n * SEQ) * 16;
#pragma unroll
      for (int it = 0; it < 8; ++it) { const int q = tid + 512 * it, token = q >> 1, half = q & 1; const v4u v = *(const v4u*)(usrc + (size_t)token * 16 + 8 * half);
          *(LAS v4u*)(lds + U_OFF + (token >> 5) * 1056 + (token & 31) * 32 + 16 * half) = v; } }
    bf16x8 wa[16];
    { S5_LAUNDER();
#pragma unroll
    for (int ks = 0; ks < 16; ++ks) wa[ks] = *(const bf16x8*)(WTg + ((size_t)(wave * 16 + ks) * 64 + lane) * 8);
    }
    __syncthreads();
    {   S5_LAUNDER();
        f32x4 accS[4];
#pragma unroll
        for (int cb = 0; cb < 4; ++cb) accS[cb] = (f32x4){0.f, 0.f, 0.f, 0.f};
#pragma unroll
        for (int ks = 0; ks < 16; ++ks) {
#pragma unroll
            for (int cb = 0; cb < 4; ++cb) { const bf16x8 b = *(const LAS bf16x8*)(lds + U_OFF + (16 * cb + fr) * 1056 + (2 * ks + (fq >> 1)) * 32 + 16 * (fq & 1));
                accS[cb] = __builtin_amdgcn_mfma_f32_16x16x32_bf16(wa[ks], b, accS[cb], 0, 0, 0); }
            if (ks & 1) asm volatile("" ::: "memory"); }
#pragma unroll
        for (int cb = 0; cb < 4; ++cb) *(LAS f32x4*)(lds + R2_OFF + ((16 * cb + fr) * 132 + 16 * wave + 4 * fq) * 4) = accS[cb];
    }
    __syncthreads();
    const int tau0 = wave, tau1 = 15 - wave, tau2 = 16 + wave, tau3 = 31 - wave;
    bf16x8 ga[4][4]; v4u ftq[4];
    { S5_LAUNDER();
#pragma unroll
      for (int it = 0; it < 4; ++it) { const int q = tid + 512 * it; ftq[it] = *(const v4u*)(FTg + (size_t)q * 8); }
#pragma unroll
      for (int kk = 0; kk < 4; ++kk) { ga[0][kk] = *(const bf16x8*)(GTg + ((size_t)(tau0 * 4 + kk) * 64 + lane) * 8); ga[1][kk] = *(const bf16x8*)(GTg + ((size_t)(tau1 * 4 + kk) * 64 + lane) * 8);
                                       ga[2][kk] = *(const bf16x8*)(GTg + ((size_t)(tau2 * 4 + kk) * 64 + lane) * 8); ga[3][kk] = *(const bf16x8*)(GTg + ((size_t)(tau3 * 4 + kk) * 64 + lane) * 8); } }
    { S5_LAUNDER(); if (tid < 64) {
        const int p = tid; const float lr = ltp[2 * p], li = ltp[2 * p + 1]; float hr = 0.f, hi = 0.f;
#pragma unroll 8
        for (int c = 0; c < S5NC; ++c) { *(LAS unsigned*)(lds + HP_OFF + c * 272 + 4 * p) = pk2(hr, hi);
            const f32x2 sv = *(const LAS f32x2*)(lds + R2_OFF + (c * 132 + 2 * p) * 4);
            const float nr = lr * hr - li * hi + sv.x, ni = lr * hi + li * hr + sv.y; hr = nr; hi = ni; }
        out_re[p] = hr; out_im[p] = hi;
    } }
    __syncthreads();
    S5_LAUNDER();
#pragma unroll
    for (int it = 0; it < 4; ++it) { const int q = tid + 512 * it; *(LAS v4u*)(lds + R2_OFF + q * 16) = ftq[it]; }
    const f32x4 dk = *(const f32x4*)(dsk + 4 * fq);
    __syncthreads();
    bf16x8 hbv[4][4];
#pragma unroll
    for (int kk = 0; kk < 4; ++kk)
#pragma unroll
        for (int cb = 0; cb < 4; ++cb) hbv[kk][cb] = *(const LAS bf16x8*)(lds + HP_OFF + (16 * cb + fr) * 272 + 64 * kk + 16 * fq);
#define S5_LOADK(FA_, UB_, KS_) do { FA_ = *(const LAS bf16x8*)(lds + R2_OFF + ((tau - 2 * (KS_)) * 64 + lane) * 16); \
        _Pragma("unroll") for (int cb = 0; cb < 4; ++cb) UB_[cb] = *(const LAS bf16x8*)(lds + U_OFF + (16 * cb + fr) * 1056 + (2 * (KS_) + (fq >> 1)) * 32 + 16 * (fq & 1)); } while (0)
#define S5_MMK(FA_, UB_) do { _Pragma("unroll") for (int cb = 0; cb < 4; ++cb) acc[cb] = __builtin_amdgcn_mfma_f32_16x16x32_bf16(FA_, UB_[cb], acc[cb], 0, 0, 0); } while (0)
#pragma unroll
    for (int j = 0; j < 4; ++j) {
        const int tau = (j == 0) ? tau0 : (j == 1) ? tau1 : (j == 2) ? tau2 : tau3;
        f32x4 acc[4];
#pragma unroll
        for (int cb = 0; cb < 4; ++cb) acc[cb] = (f32x4){0.f, 0.f, 0.f, 0.f};
        {
            const int nks = (tau >> 1) + 1;
            bf16x8 fa0, fa1, ub0[4], ub1[4];
            S5_LOADK(fa0, ub0, 0);
#pragma unroll 1
            for (int ks = 0; ks < nks; ks += 2) {
                if (ks + 1 < nks) S5_LOADK(fa1, ub1, ks + 1);
                S5_MMK(fa0, ub0);
                if (ks + 2 < nks) S5_LOADK(fa0, ub0, ks + 2);
                if (ks + 1 < nks) S5_MMK(fa1, ub1);
            }
        }
#pragma unroll
        for (int kk = 0; kk < 4; ++kk)
#pragma unroll
            for (int cb = 0; cb < 4; ++cb) acc[cb] = __builtin_amdgcn_mfma_f32_16x16x32_bf16(ga[j][kk], hbv[kk][cb], acc[cb], 0, 0, 0);
#pragma unroll
        for (int cb = 0; cb < 4; ++cb) { const int tok = (16 * cb + fr) * S5T + tau;
            const v2u uu = *(const LAS v2u*)(lds + U_OFF + (16 * cb + fr) * 1056 + tau * 32 + 8 * fq);
            const float y0 = gelu_tanh(acc[cb][0] + dk[0] * bflo(uu.x)), y1 = gelu_tanh(acc[cb][1] + dk[1] * bfhi(uu.x)), y2 = gelu_tanh(acc[cb][2] + dk[2] * bflo(uu.y)), y3 = gelu_tanh(acc[cb][3] + dk[3] * bfhi(uu.y));
            v2u o; o.x = pk2(y0, y1); o.y = pk2(y2, y3);
            *(v2u*)(YS + ((size_t)n * SEQ + tok) * SSMW + g * 16 + 4 * fq) = o; }
    }
    __syncthreads();
#undef S5_LOADK
#undef S5_MMK
#undef S5_LAUNDER
}
__device__ __forceinline__ void gmlp_prompt_item(LAS unsigned char* lds, int tid, int lane, int wave, size_t row0, const bf16* VG, const bf16* UG, const float* VST,
                                                 const bf16* wsm, const float* wsums, const float* g_v, const float* b_v, const float* b_s, bf16* YCAT, float* GQ, int h0) {
    LAS bf16* vT = (LAS bf16*)lds;
    LAS float* mu = (LAS float*)(lds + 128 * 136 * 2);
    LAS float* rs = mu + 128;
    LAS float* red = rs + 128;
    const int fr = lane & 15, fq = lane >> 4;
    if (tid < 128) { const f32x4* q = (const f32x4*)(VST + (row0 + tid) * 16); const f32x4 a = q[0], b = q[1], c = q[2], d = q[3];
        const float s1 = (a[0] + a[2]) + (b[0] + b[2]) + (c[0] + c[2]) + (d[0] + d[2]), s2 = (a[1] + a[3]) + (b[1] + b[3]) + (c[1] + c[3]) + (d[1] + d[3]);
        const float m = s1 * (1.0f / 512.0f); float var = s2 * (1.0f / 512.0f) - m * m; var = var > 0.f ? var : 0.f;
        mu[tid] = m; rs[tid] = __builtin_amdgcn_rsqf(var + NORM_EPS); }
    __syncthreads();
    float sq[8];
#pragma unroll
    for (int i = 0; i < 8; ++i) sq[i] = 0.f;
    v4u vq[4]; v2u uqn[8]; float biasn[8];
#pragma unroll
    for (int it = 0; it < 4; ++it) { const int piece = tid + 512 * it; vq[it] = *(const v4u*)(VG + (row0 + (piece & 127)) * GMW + h0 * 128 + 8 * (piece >> 7)); }
#pragma unroll
    for (int tb = 0; tb < 8; ++tb) { uqn[tb] = *(const v2u*)(UG + (row0 + 16 * tb + fr) * GMW + h0 * 128 + 16 * wave + 4 * fq); biasn[tb] = b_s[h0 * 128 + 16 * tb + fr]; }
#pragma unroll 1
    for (int h = h0; h < h0 + 2; ++h) {
#pragma unroll
        for (int it = 0; it < 4; ++it) { const int piece = tid + 512 * it, s = piece & 127, c0 = 8 * (piece >> 7);
            const v4u q = vq[it];
            const float m = mu[s], r = rs[s];
            LAS bf16* d = vT + c0 * 136 + s;
            const unsigned p0 = pk2((bflo(q.x) - m) * r, (bfhi(q.x) - m) * r), p1 = pk2((bflo(q.y) - m) * r, (bfhi(q.y) - m) * r), p2 = pk2((bflo(q.z) - m) * r, (bfhi(q.z) - m) * r), p3 = pk2((bflo(q.w) - m) * r, (bfhi(q.w) - m) * r);
            d[0 * 136] = (bf16)p0; d[1 * 136] = (bf16)(p0 >> 16); d[2 * 136] = (bf16)p1; d[3 * 136] = (bf16)(p1 >> 16);
            d[4 * 136] = (bf16)p2; d[5 * 136] = (bf16)(p2 >> 16); d[6 * 136] = (bf16)p3; d[7 * 136] = (bf16)(p3 >> 16); }
        v2u uq[8]; float bias[8];
#pragma unroll
        for (int tb = 0; tb < 8; ++tb) { uq[tb] = uqn[tb]; bias[tb] = biasn[tb]; }
        if (h == h0) {
#pragma unroll
            for (int it = 0; it < 4; ++it) { const int piece = tid + 512 * it; vq[it] = *(const v4u*)(VG + (row0 + (piece & 127)) * GMW + (h + 1) * 128 + 8 * (piece >> 7)); }
#pragma unroll
            for (int tb = 0; tb < 8; ++tb) { uqn[tb] = *(const v2u*)(UG + (row0 + 16 * tb + fr) * GMW + (h + 1) * 128 + 16 * wave + 4 * fq); biasn[tb] = b_s[(h + 1) * 128 + 16 * tb + fr]; } }
        bf16x8 bw[12]; float wsv[8];
        unsigned wlo = (unsigned)(fr * 128 + 8 * fq) * 2u, slo = (unsigned)fr * 4u; asm volatile("" : "+v"(wlo), "+v"(slo));
        const GAS char* wbase = (const GAS char*)(wsm + (size_t)h * 128 * 128); const GAS char* sbase = (const GAS char*)(wsums + h * 128);
        { int idx_ = 0;
#pragma unroll
          for (int tb = 0; tb < 8; ++tb) {
#pragma unroll
              for (int ks = 0; ks <= (tb >> 1); ++ks) if (tb < 6) bw[idx_++] = *(const GAS bf16x8*)(wbase + (tb * 16 * 128 + ks * 32) * 2 + wlo);
              wsv[tb] = *(const GAS float*)(sbase + tb * 64 + slo); } }
        const f32x4 gc = *(const GAS f32x4*)(g_v + h * 128 + 16 * wave + 4 * fq), bc = *(const GAS f32x4*)(b_v + h * 128 + 16 * wave + 4 * fq);
        __syncthreads();
        bf16x8 a[4];
#pragma unroll
        for (int ks = 0; ks < 4; ++ks) a[ks] = *(const LAS bf16x8*)(vT + (16 * wave + fr) * 136 + 32 * ks + 8 * fq);
        f32x4 accs[8];
        { int idx_ = 0;
#pragma unroll
          for (int tb = 0; tb < 6; ++tb) { accs[tb] = (f32x4){0.f, 0.f, 0.f, 0.f};
#pragma unroll
              for (int ks = 0; ks <= (tb >> 1); ++ks) accs[tb] = __builtin_amdgcn_mfma_f32_16x16x32_bf16(a[ks], bw[idx_++], accs[tb], 0, 0, 0); } }
        __builtin_amdgcn_sched_barrier(0);
        bf16x8 bw2[8];
#pragma unroll
        for (int tb = 6; tb < 8; ++tb)
#pragma unroll
            for (int ks = 0; ks < 4; ++ks) bw2[(tb - 6) * 4 + ks] = *(const GAS bf16x8*)(wbase + (tb * 16 * 128 + ks * 32) * 2 + wlo);
        __builtin_amdgcn_sched_barrier(0);
#pragma unroll
        for (int tb = 0; tb < 8; ++tb) {
            if (tb >= 6) { accs[tb] = (f32x4){0.f, 0.f, 0.f, 0.f};
#pragma unroll
                for (int ks = 0; ks < 4; ++ks) accs[tb] = __builtin_amdgcn_mfma_f32_16x16x32_bf16(a[ks], bw2[(tb - 6) * 4 + ks], accs[tb], 0, 0, 0); }
            const f32x4 acc = accs[tb];
            const int t = 16 * tb + fr;
            const float wsum = wsv[tb];
            f32x4 y; y[0] = bflo(uq[tb].x) * (gc[0] * acc[0] + bc[0] * wsum + bias[tb]); y[1] = bfhi(uq[tb].x) * (gc[1] * acc[1] + bc[1] * wsum + bias[tb]);
            y[2] = bflo(uq[tb].y) * (gc[2] * acc[2] + bc[2] * wsum + bias[tb]); y[3] = bfhi(uq[tb].y) * (gc[3] * acc[3] + bc[3] * wsum + bias[tb]);
            sq[tb] += (y[0] * y[0] + y[1] * y[1]) + (y[2] * y[2] + y[3] * y[3]);
            v2u o; o.x = pk2(y[0], y[1]); o.y = pk2(y[2], y[3]);
            *(GAS v2u*)(YCAT + (row0 + t) * DM + 512 + h * 128 + 16 * wave + 4 * fq) = o;
        }
        __syncthreads();
    }
#pragma unroll
    for (int tb = 0; tb < 8; ++tb) { float s = sq[tb]; s += fshx<16>(s); s += fshx<32>(s); if (fq == 0) red[wave * 128 + 16 * tb + fr] = s; }
    __syncthreads();
    if (tid < 128) { float tot = 0.f;
#pragma unroll
        for (int w = 0; w < 8; ++w) tot += red[w * 128 + tid];
        GQ[row0 + tid] = tot; }
    __syncthreads();
}
__device__ __forceinline__ void gmlp_sample_item(LAS unsigned char* lds, int tid, int lane, int wave, int b, const bf16* VG, const bf16* UG,
                                                 const float* w_s, const float* g_v, const float* b_v, const float* b_s, bf16* YCAT, float* vs_out) {
    LAS float* red = (LAS float*)lds;
    const int c = tid, h = c >> 7;
    const size_t row0 = (size_t)MP + b * DECS;
    float vv[4], vn[4], y[4];
    const float gv = g_v[c], bv = b_v[c];
#pragma unroll
    for (int j = 0; j < 4; ++j) { vv[j] = bf1(VG[(row0 + j) * GMW + c]); const float s1 = wave_sum(vv[j]), s2 = wave_sum(vv[j] * vv[j]); if (lane == 0) { red[wave * 8 + 2 * j] = s1; red[wave * 8 + 2 * j + 1] = s2; } }
    __syncthreads();
#pragma unroll
    for (int j = 0; j < 4; ++j) { float s1 = 0.f, s2 = 0.f;
#pragma unroll
        for (int w = 0; w < 8; ++w) { s1 += red[w * 8 + 2 * j]; s2 += red[w * 8 + 2 * j + 1]; }
        const float m = s1 * (1.0f / 512.0f); float var = s2 * (1.0f / 512.0f) - m * m; var = var > 0.f ? var : 0.f;
        vn[j] = (vv[j] - m) * __builtin_amdgcn_rsqf(var + NORM_EPS) * gv + bv;
        vs_out[((size_t)b * DECS + j) * GMW + c] = vn[j]; }
    __syncthreads();
#pragma unroll
    for (int t = 0; t < 4; ++t) { float mix = b_s[h * CHUNK + t];
#pragma unroll
        for (int s = 0; s <= t; ++s) mix += w_s[((size_t)h * CHUNK + t) * CHUNK + s] * vn[s];
        y[t] = bf1(UG[(row0 + t) * GMW + c]) * mix; }
#pragma unroll
    for (int t = 0; t < 4; ++t) { const float s = wave_sum(y[t] * y[t]); if (lane == 0) red[wave * 4 + t] = s; }
    __syncthreads();
#pragma unroll
    for (int t = 0; t < 4; ++t) { float tot = 0.f;
#pragma unroll
        for (int w = 0; w < 8; ++w) tot += red[w * 4 + t];
        YCAT[(row0 + t) * DM + 512 + c] = (bf16)f2bf(y[t] * __builtin_amdgcn_rsqf(tot * (1.0f / 512.0f) + NORM_EPS)); }
    __syncthreads();
}

template <int TN, int WK, int WN, int K, int U, int MB = 2, bool PREBAR = false, class F>
__device__ __forceinline__ void small_gemm_tile(LAS unsigned char* lds, int tid, const bf16* A, int lda, const bf16* Bt, int row0, int col0, const F& f) {
    static_assert(WK * WN == 8 && TN % (16 * WN) == 0 && (K / WK) % (32 * U) == 0, "wave split");
    constexpr int NBW = TN / (16 * WN), P = TN + 4, KPER = K / WK;
    const int lane = tid & 63, wave = __builtin_amdgcn_readfirstlane(tid >> 6), wk = wave / WN, wn = wave % WN, fr = lane & 15, fq = lane >> 4;
    const int k0 = wk * KPER;
    f32x4 acc[MB][NBW];
#pragma unroll
    for (int m = 0; m < MB; ++m)
#pragma unroll
        for (int n = 0; n < NBW; ++n) acc[m][n] = (f32x4){0.f, 0.f, 0.f, 0.f};
    const bf16* ap = A + (size_t)(row0 + fr) * lda + k0 + 8 * fq;
    const bf16* bp = Bt + (size_t)(col0 + wn * (TN / WN) + fr) * K + k0 + 8 * fq;
    bf16x8 a0[2][U], a1[2][U], b[2][U][NBW];
#define SGT_LOAD(S_, KS_) do { _Pragma("unroll") for (int u = 0; u < U; ++u) { a0[S_][u] = *(const bf16x8*)(ap + (KS_) + 32 * u); if (MB == 2) a1[S_][u] = *(const bf16x8*)(ap + (size_t)16 * lda + (KS_) + 32 * u); \
        _Pragma("unroll") for (int n = 0; n < NBW; ++n) b[S_][u][n] = *(const bf16x8*)(bp + (size_t)n * 16 * K + (KS_) + 32 * u); } } while (0)
#define SGT_MMA(S_) do { _Pragma("unroll") for (int u = 0; u < U; ++u) _Pragma("unroll") for (int n = 0; n < NBW; ++n) { acc[0][n] = __builtin_amdgcn_mfma_f32_16x16x32_bf16(b[S_][u][n], a0[S_][u], acc[0][n], 0, 0, 0); \
        if (MB == 2) acc[MB - 1][n] = __builtin_amdgcn_mfma_f32_16x16x32_bf16(b[S_][u][n], a1[S_][u], acc[MB - 1][n], 0, 0, 0); } } while (0)
    constexpr bool ONEPASS = 16 * MB * (TN / 4) <= NWAVES * 64;
    typename F::Pre pre{};
    if constexpr (ONEPASS) { if (tid < 16 * MB * (TN / 4)) pre = f.prefetch(tid / (TN / 4), 4 * (tid % (TN / 4))); }
    SGT_LOAD(0, 0);
#pragma unroll 1
    for (int ks = 0; ks < KPER; ks += 64 * U) {
        if (ks + 32 * U < KPER) SGT_LOAD(1, ks + 32 * U);
        SGT_MMA(0);
        if (ks + 64 * U < KPER) SGT_LOAD(0, ks + 64 * U);
        if (ks + 32 * U < KPER) SGT_MMA(1);
    }
#undef SGT_LOAD
#undef SGT_MMA
    if constexpr (PREBAR) { asm volatile("s_waitcnt vmcnt(0)" ::: "memory"); __syncthreads(); }
    LAS float* red = (LAS float*)lds;
#pragma unroll
    for (int m = 0; m < MB; ++m)
#pragma unroll
        for (int n = 0; n < NBW; ++n) *(LAS f32x4*)(red + (size_t)((wk * 16 * MB + 16 * m + fr) * P + wn * (TN / WN) + 16 * n + 4 * fq)) = acc[m][n];
    __syncthreads();
#pragma unroll 1
    for (int e = tid; e < 16 * MB * (TN / 4); e += NWAVES * 64) { const int row = e / (TN / 4), c4 = 4 * (e % (TN / 4));
        f32x4 v = *(const LAS f32x4*)(red + (size_t)(row * P + c4));
#pragma unroll
        for (int w = 1; w < WK; ++w) v = v + *(const LAS f32x4*)(red + (size_t)((w * 16 * MB + row) * P + c4));
        if constexpr (ONEPASS) f(row, c4, v, pre); else f(row, c4, v, f.prefetch(row, c4)); }
    __syncthreads();
}
struct SF_In { int grow0, gcol0; const float* ssq; bf16* US; size_t seg_stride;
    struct Pre {}; __device__ __forceinline__ Pre prefetch(int, int) const { return Pre{}; }
    __device__ __forceinline__ void operator()(int row, int col, f32x4 v, const Pre&) const { const int gr = grow0 + row, gc = gcol0 + col, seg = gc >> 9, c = gc & 511;
        const float r = rinv16(ssq, gr, 1.0f / 1024.0f); v = v * r;
        if (seg != 0) { v[0] = gelu_tanh(v[0]); v[1] = gelu_tanh(v[1]); v[2] = gelu_tanh(v[2]); v[3] = gelu_tanh(v[3]); }
        v2u o; o.x = pk2(v[0], v[1]); o.y = pk2(v[2], v[3]);
        if (seg == 0) *(v2u*)(US + ((size_t)(c >> 4) * M + gr) * 16 + (c & 15)) = o;
        else *(v2u*)(US + (size_t)seg * seg_stride + (size_t)gr * 512 + c) = o; } };
struct SF_Plain { int grow0, gcol0; bf16* O; int ldo;
    struct Pre {}; __device__ __forceinline__ Pre prefetch(int, int) const { return Pre{}; }
    __device__ __forceinline__ void operator()(int row, int col, f32x4 v, const Pre&) const { v2u o; o.x = pk2(v[0], v[1]); o.y = pk2(v[2], v[3]); *(v2u*)(O + (size_t)(grow0 + row) * ldo + gcol0 + col) = o; } };
struct SF_Up { int grow0, gcol0; const float* ssq; bf16* HID;
    struct Pre {}; __device__ __forceinline__ Pre prefetch(int, int) const { return Pre{}; }
    __device__ __forceinline__ void operator()(int row, int col, f32x4 v, const Pre&) const { const int gr = grow0 + row; const float r = rinv16(ssq, gr, 1.0f / 1024.0f);
#pragma unroll
        for (int j = 0; j < 4; ++j) { const float a = fmaxf(v[j] * r, 0.f); v[j] = a * a; }
        v2u o; o.x = pk2(v[0], v[1]); o.y = pk2(v[2], v[3]); *(v2u*)(HID + (size_t)gr * FF + gcol0 + col) = o; } };
template <bool GATED, bool WT = false> struct SF_Res { int grow0, gcol0; const bf16* hin; bf16* hb; float* ssq_out; const float* ssq_in; const bf16* pl;
    struct Pre { v2u hq, pv; f32x4 s0, s1, s2, s3; };
    __device__ __forceinline__ Pre prefetch(int row, int col) const { Pre p{}; const int gr = grow0 + row; const size_t off = (size_t)gr * DM + gcol0 + col;
        p.hq = *(const v2u*)(hin + off);
        if (GATED) { p.pv = *(const v2u*)(pl + off); const f32x4* q = (const f32x4*)(ssq_in + (size_t)gr * 16); p.s0 = q[0]; p.s1 = q[1]; p.s2 = q[2]; p.s3 = q[3]; }
        return p; }
    __device__ __forceinline__ void operator()(int row, int col, f32x4 a, const Pre& p) const { const int gr = grow0 + row; const size_t off = (size_t)gr * DM + gcol0 + col;
        const v2u hq = p.hq; f32x4 hv = (f32x4){bflo(hq.x), bfhi(hq.x), bflo(hq.y), bfhi(hq.y)};
        if (GATED) { const float ss = ((p.s0[0] + p.s0[1]) + (p.s0[2] + p.s0[3])) + ((p.s1[0] + p.s1[1]) + (p.s1[2] + p.s1[3])) + ((p.s2[0] + p.s2[1]) + (p.s2[2] + p.s2[3])) + ((p.s3[0] + p.s3[1]) + (p.s3[2] + p.s3[3]));
            const float r = __builtin_amdgcn_rsqf(ss * (1.0f / 1024.0f) + NORM_EPS); const v2u pv = p.pv;
            a[0] = sigmoid_f(a[0] * r) * bflo(pv.x); a[1] = sigmoid_f(a[1] * r) * bfhi(pv.x); a[2] = sigmoid_f(a[2] * r) * bflo(pv.y); a[3] = sigmoid_f(a[3] * r) * bfhi(pv.y); }
        hv = hv + a; v2u o; o.x = pk2(hv[0], hv[1]); o.y = pk2(hv[2], hv[3]);
        if (WT) __hip_atomic_store((unsigned long long*)(hb + off), (unsigned long long)o.x | ((unsigned long long)o.y << 32), __ATOMIC_RELAXED, __HIP_MEMORY_SCOPE_AGENT); else *(v2u*)(hb + off) = o;
        float sq = (hv[0] * hv[0] + hv[1] * hv[1]) + (hv[2] * hv[2] + hv[3] * hv[3]);
        sq += fshx<1>(sq); sq += fshx<2>(sq); sq += fshx<4>(sq); sq += fshx<8>(sq);
        if ((col >> 2) == 0) { if (WT) __hip_atomic_store(&ssq_out[(size_t)gr * 16 + (gcol0 >> 6)], sq, __ATOMIC_RELAXED, __HIP_MEMORY_SCOPE_AGENT); else ssq_out[(size_t)gr * 16 + (gcol0 >> 6)] = sq; } } };
struct SF_Glu { LAS float* red; int grow0; const bf16* YS; const float* bias;
    struct Pre {}; __device__ __forceinline__ Pre prefetch(int, int) const { return Pre{}; }
    __device__ __forceinline__ void operator()(int row, int col, f32x4 v, const Pre&) const { const v2u yq = *(const v2u*)(YS + (size_t)(grow0 + row) * SSMW + col); const f32x4 b = *(const f32x4*)(bias + col);
        v[0] = bflo(yq.x) * sigmoid_f(v[0] + b[0]); v[1] = bfhi(yq.x) * sigmoid_f(v[1] + b[1]); v[2] = bflo(yq.y) * sigmoid_f(v[2] + b[2]); v[3] = bfhi(yq.y) * sigmoid_f(v[3] + b[3]);
        *(LAS f32x4*)(red + (size_t)(row * 516 + col)) = v; } };
#define SAMPLE_TILES_64(Aptr, lda_, Bptr, K_, U_, FUNCTOR_INIT) do { for (int t_ = bx; t_ < 256; t_ += G) { const int grow0 = MP + 32 * (t_ >> 4), gcol0 = 64 * (t_ & 15); \
        auto f_ = FUNCTOR_INIT; small_gemm_tile<64, 8, 1, K_, U_>(lds, tid, (Aptr), (lda_), (Bptr), grow0, gcol0, f_); } } while (0)
#define SAMPLE_TILES_64_PB(Aptr, lda_, Bptr, K_, U_, FUNCTOR_INIT) do { static_assert(true, ""); for (int t_ = bx; t_ < 256; t_ += G) { const int grow0 = MP + 32 * (t_ >> 4), gcol0 = 64 * (t_ & 15); \
        auto f_ = FUNCTOR_INIT; small_gemm_tile<64, 8, 1, K_, U_, 2, true>(lds, tid, (Aptr), (lda_), (Bptr), grow0, gcol0, f_); } \
        if (bx >= 256) { VM_WAIT(); __syncthreads(); }     } while (0)
#define FILL_RTAB(SCHED, SSQP) do { int t_ = threadIdx.x; asm volatile("" : "+v"(t_)); pg8::Unit u_; int ppm_ = -1; float pr_ = 0.f; \
        for (int i_ = 0; i_ < 8 && (SCHED).next(i_, u_); ++i_) { if (u_.pm != ppm_) { if (t_ < 256) pr_ = rinv16((SSQP), u_.pm * 256 + t_, 1.0f / 1024.0f); ppm_ = u_.pm; }     \
            if (t_ < 256) ((LAS float*)(lds + RT_OFF))[i_ * 256 + t_] = pr_; } \
        __syncthreads(); } while (0)

__device__ __forceinline__ void final_norm_rows(float* y, const bf16* hz, const float* ssq, const float* gf, int m_lo, int m_hi, int widx, int nw, int lane) {
    for (int m0 = m_lo + widx; m0 < m_hi; m0 += 3 * nw) {
        f32x4 sp[3][4]; v4u hq[3][2];
#pragma unroll
        for (int q = 0; q < 3; ++q) { const int m = m0 + q * nw; if (m < m_hi) { const f32x4* p = (const f32x4*)(ssq + (size_t)m * 16); sp[q][0] = p[0]; sp[q][1] = p[1]; sp[q][2] = p[2]; sp[q][3] = p[3];
            const GAS v4u* hr = (const GAS v4u*)(hz + (size_t)m * DM) + lane; hq[q][0] = hr[0]; hq[q][1] = hr[64]; } }
#pragma unroll
        for (int q = 0; q < 3; ++q) { const int m = m0 + q * nw; if (m < m_hi) { float s = 0.f;
#pragma unroll
            for (int j = 0; j < 4; ++j) s += (sp[q][j][0] + sp[q][j][1]) + (sp[q][j][2] + sp[q][j][3]);
            const float r = __builtin_amdgcn_rsqf(s * (1.0f / 1024.0f) + NORM_EPS);
            GAS f32x4* yr = (GAS f32x4*)(y + (size_t)m * DM); const GAS f32x4* gr = (const GAS f32x4*)gf;
#pragma unroll
            for (int j = 0; j < 2; ++j) { const v4u w = hq[q][j]; const int c = 2 * (lane + 64 * j);
                const f32x4 g0 = gr[c], g1 = gr[c + 1];
                yr[c] = (f32x4){bflo(w.x) * r * g0[0], bfhi(w.x) * r * g0[1], bflo(w.y) * r * g0[2], bfhi(w.y) * r * g0[3]};
                yr[c + 1] = (f32x4){bflo(w.z) * r * g1[0], bfhi(w.z) * r * g1[1], bflo(w.w) * r * g1[2], bfhi(w.w) * r * g1[3]}; } } }
    }
}
constexpr int CW_FIN = 16384, CW_FINS = CW_FIN + 64 * 64;
static_assert((CW_FINS + 16 * 64) * 4 <= (int)CTL_ZERO_BYTES, "control words");
namespace pg8 {
struct EpiFin {
    static constexpr bool PERM = true, AFTER_DRAIN = false, MIDSCALE = false, PREHOOK = true;
    const bf16_t* hin; float* ssq_out; const float* ssq_in; const bf16_t* pl; const PG8_LAS float* rtab; PG8_LAS float* rt2; float* y; const float* gfin; unsigned* cnt; unsigned* bar; unsigned nteam; PG8_LAS unsigned char* ring; RtPre pre = {};
    template <class Sched> __device__ __forceinline__ void prehook(const Sched& S, const Unit& u0) const { rtab_hook(S, u0, pre, ssq_in, (PG8_LAS float*)rtab); }
    __device__ __forceinline__ void operator()(const f32x4 (&acc_)[2][2][4][2], const Unit& u, int wr, int wc, int fr, int fq) const {
        f32x4 (&acc)[2][2][4][2] = const_cast<f32x4 (&)[2][2][4][2]>(acc_);
        int upm = u.pm, upn = u.pn; asm volatile("" : "+s"(upm), "+s"(upn));
        const int row0 = upm * BM + wr * 64 + fr, col0 = upn * BM + wc * 32 + 8 * fq;
        constexpr int NPF = 2;
#pragma unroll
        for (int ai = 0; ai < 2; ++ai)
#pragma unroll
            for (int mp = 0; mp < 4 / NPF; ++mp) {
                u32x4 hv[NPF][2]; u32x4 pv[NPF][2];
#pragma unroll
                for (int mm = 0; mm < NPF; ++mm) { const int row = row0 + ai * HALF + (NPF * mp + mm) * 16;
#pragma unroll
                    for (int bj = 0; bj < 2; ++bj) { const size_t off = (size_t)row * 1024 + col0 + bj * HALF; hv[mm][bj] = *(const u32x4*)(hin + off); pv[mm][bj] = *(const u32x4*)(pl + off); } }
#pragma unroll
                for (int mm = 0; mm < NPF; ++mm) { const int m = NPF * mp + mm, row = row0 + ai * HALF + m * 16;
                    const float r = (u.ui < 8) ? rtab[u.ui * 256 + wr * 64 + fr + ai * HALF + m * 16] : rinv16(ssq_in, row, 1.0f / 1024.0f);
                    float sq = 0.f;
#pragma unroll
                    for (int bj = 0; bj < 2; ++bj) {
                        f32x4 a0 = acc[ai][bj][m][0], a1 = acc[ai][bj][m][1]; const u32x4 hq = hv[mm][bj], p4 = pv[mm][bj];
                        f32x4 x0 = (f32x4){bf_lo(hq.x), bf_hi(hq.x), bf_lo(hq.y), bf_hi(hq.y)}, x1 = (f32x4){bf_lo(hq.z), bf_hi(hq.z), bf_lo(hq.w), bf_hi(hq.w)};
                        a0[0] = sigmoid_f(a0[0] * r) * bf_lo(p4.x); a0[1] = sigmoid_f(a0[1] * r) * bf_hi(p4.x); a0[2] = sigmoid_f(a0[2] * r) * bf_lo(p4.y); a0[3] = sigmoid_f(a0[3] * r) * bf_hi(p4.y);
                        a1[0] = sigmoid_f(a1[0] * r) * bf_lo(p4.z); a1[1] = sigmoid_f(a1[1] * r) * bf_hi(p4.z); a1[2] = sigmoid_f(a1[2] * r) * bf_lo(p4.w); a1[3] = sigmoid_f(a1[3] * r) * bf_hi(p4.w);
                        x0 = x0 + a0; x1 = x1 + a1;
                        acc[ai][bj][m][0] = x0; acc[ai][bj][m][1] = x1;
                        sq += ((x0[0] * x0[0] + x0[1] * x0[1]) + (x0[2] * x0[2] + x0[3] * x0[3])) + ((x1[0] * x1[0] + x1[1] * x1[1]) + (x1[2] * x1[2] + x1[3] * x1[3])); }
                    sq += fshx<16>(sq); sq += fshx<32>(sq);
                    if (fq == 0) __hip_atomic_store(&ssq_out[(size_t)row * 16 + upn * 4 + wc], sq, __ATOMIC_RELAXED, __HIP_MEMORY_SCOPE_AGENT); }
                asm volatile("" ::: "memory");
            }
        asm volatile("s_waitcnt vmcnt(0)" ::: "memory");
        __syncthreads();
        if (threadIdx.x == 0) {
            (void)xb_add(&cnt[upm * 64], 1u);
            XB_SPIN(xb_ld(&cnt[upm * 64]) < nteam, bar);
            __builtin_amdgcn_fence(__ATOMIC_ACQUIRE, "agent");
            asm volatile("s_waitcnt vmcnt(0)" ::: "memory");
        }
        __syncthreads();
        { int t_ = threadIdx.x; asm volatile("" : "+v"(t_)); if (t_ < 256) rt2[t_] = rinv16(ssq_out, upm * BM + t_, 1.0f / 1024.0f); }
        __syncthreads();
        f32x4 gq[2][2];
#pragma unroll
        for (int bj = 0; bj < 2; ++bj) { gq[bj][0] = *(const f32x4*)(gfin + col0 + bj * HALF); gq[bj][1] = *(const f32x4*)(gfin + col0 + bj * HALF + 4); }
        PG8_LAS float* stg = (PG8_LAS float*)ring; const int wave = wr * 4 + wc, lane = fr + 16 * fq;
#pragma unroll
        for (int ai = 0; ai < 2; ++ai) {
#pragma unroll
            for (int m = 0; m < 4; ++m) { const int rl = wr * 64 + m * 16 + fr; const float r = rt2[rl + ai * HALF];
#pragma unroll
                for (int bj = 0; bj < 2; ++bj)
#pragma unroll
                    for (int n = 0; n < 2; ++n) { const int c16 = (bj * 32 + wc * 8 + 2 * fq + n) ^ fr;
                        *(PG8_LAS f32x4*)(stg + rl * 256 + c16 * 4) = acc[ai][bj][m][n] * r * gq[bj][n]; } }
            __syncthreads();
#pragma unroll 4
            for (int rr = 0; rr < 16; ++rr) { const int rl = wave * 16 + rr; const f32x4 v = *(const PG8_LAS f32x4*)(stg + rl * 256 + lane * 4);
                *(f32x4*)(y + (size_t)(upm * BM + ai * HALF + rl) * 1024 + upn * BM + 4 * (lane ^ (rl & 15))) = v; }
            __syncthreads();
        }
    }
};
}
__global__ void __launch_bounds__(NWAVES * 64, 2) hymba_fwd(Args args) {
    extern __shared__ __attribute__((aligned(16))) unsigned char lds_raw[];
    LAS unsigned char* lds = (LAS unsigned char*)lds_raw;
    volatile LAS unsigned* MISC = (volatile LAS unsigned*)(lds + MISC_OFF);
    const int tid = threadIdx.x, lane = tid & 63, wave = __builtin_amdgcn_readfirstlane(tid >> 6);
    const int G0 = gridDim.x, bx0 = blockIdx.x;
    const int G = G0, bx = bx0;
    const bool FUSED_FINAL = (N_LAUNCHES == 1) && G == (MP / 256) * (DM / 256);
    unsigned char* ws = GPTR(unsigned char, args.ws);
    gu32* ctl = (gu32*)(ws + WS_CTL);
    for (int u = tid; u < (LDS_BYTES - LDSCTL_OFF) / 4; u += NWAVES * 64) ((LAS unsigned*)(lds + LDSCTL_OFF))[u] = 0u;
    __syncthreads();
    XcdBarrier bar; bar.bar = (unsigned*)(ctl + CW_BAR); bar.x = 0; bar.st = nullptr;
    if (N_LAUNCHES == 1) bar = xcd_barrier_post((unsigned*)(ctl + CW_BAR), MISC + 8);
#define GRID_BAR() do { if (N_LAUNCHES == 1) xcd_barrier(bar); } while (0)
    const int lo = args.ph_lo, hi = args.ph_hi;
#define IN(k) (lo <= (k) && (k) < hi)
#define BOTH(k) (IN(k) && IN((k) + 1))

#define PHASE_PTRS() int G = G0, bx = bx0; asm volatile("" : "+s"(G), "+s"(bx)); unsigned char* ws_ = args.ws; float* out__ = args.out; asm volatile("" : "+s"(ws_), "+s"(out__)); unsigned char* ws = GPTR(unsigned char, ws_); float* out_ = GPTR(float, out__); \
    float* hres = out_ + O_Y; bf16* HB = (bf16*)(ws + WS_HB); bf16* PL = (bf16*)(ws + WS_PL); \
    float* VST = (float*)(ws + WS_VST); float* GS = (float*)(ws + WS_GS); \
    bf16* US = (bf16*)(ws + WS_OVL + OV_US); bf16* UG = (bf16*)(ws + WS_OVL + OV_UG); bf16* VG = (bf16*)(ws + WS_OVL + OV_VG); bf16* YS = (bf16*)(ws + WS_OVL + OV_YS); \
    bf16* YCAT = (bf16*)(ws + WS_OVL + OV_YCAT); bf16* PB = (bf16*)((unsigned char*)out_ + 36 * MiB);     bf16* HID = (bf16*)(ws + WS_OVL); \
    bf16* HBY = (bf16*)out_; bf16* HBZ = (bf16*)(ws + WS_OVL); const bf16* HIN = (L == 0) ? HB : HBY; bf16* HOUT7 = (L == DEPTH - 1) ? HBZ : HBY; \
    const unsigned char* wl = ws + WS_W + (size_t)L * W_LAYER; \
    float* SA = (float*)(ws + ((L & 1) ? WS_SSQ1 : WS_SSQ0)); float* SB = (float*)(ws + ((L & 1) ? WS_SSQ0 : WS_SSQ1)); \
    const float* tb = (const float*)(ws + WS_TB) + (size_t)L * TB_LAYER; \
    (void)hres; (void)HB; (void)PL; (void)VST; (void)GS; (void)US; (void)UG; (void)VG; (void)YS; (void)YCAT; (void)PB; (void)HID; (void)HBY; (void)HBZ; (void)HIN; (void)HOUT7; (void)wl; (void)SA; (void)SB; (void)tb

    if (PHON(0) && IN(0)) { p0_prologue(args, lds, tid, lane, wave, bx, G); if (BOTH(0)) GRID_BAR(); }

#pragma unroll 1
    for (int L = 0; L < DEPTH; ++L) {
        const int pb = 1 + 7 * L;
        if (PHON(1) && IN(pb + 0)) {
            PHASE_PTRS();
            const bool conv_first = ((bx >> 3) & 1) != 0;
#pragma unroll 1
            for (int s_ = 0; s_ < 2; ++s_) {
                if (L == 0 && (s_ == 0) == conv_first) { int tid = threadIdx.x; asm volatile("" : "+v"(tid)); const int lane = tid & 63, wave = __builtin_amdgcn_readfirstlane(tid >> 6);
                    __syncthreads(); p0_convert(args, lds, lane, wave, bx * NWAVES + wave, G * NWAVES, P0_I_IN, P0_I_LAYER); __syncthreads(); }
                if (s_ != 0) continue;
            pg8::Gemm g{HIN, (const bf16*)(wl + WO_IN), MP, INW, opq(DM), 0, 0, (bx & 7) * 2}; pg8::StaticOrder S; S.init(MP, INW, G, bx);
            pg8::EpiAct<0> E{US, SSMW, (OV_UG - OV_US) / 2, M, SA, VST, nullptr, nullptr, (const LAS float*)(lds + RT_OFF)};
            { int t_ = threadIdx.x; asm volatile("" : "+v"(t_)); pg8::Unit u0_; if (S.next(0, u0_) && t_ < 256) E.pre = pg8::rtpre_load(SA, u0_.pm * 256 + t_); }
            pg8::gemm_phase<pg8::EpiAct<0>, pg8::StaticOrder, PG8_ALIGN, PG8_SP2>(lds, g, S, E);
            { int tid = threadIdx.x; asm volatile("" : "+v"(tid));
              for (int t_ = bx; t_ < 256; t_ += G) { const int grow0 = MP + 32 * (t_ >> 4), gcol0 = 96 * (t_ & 15);
                  SF_In f_{grow0, gcol0, SA, US, (OV_UG - OV_US) / 2}; small_gemm_tile<96, 8, 1, DM, 4>(lds, tid, HIN, DM, (const bf16*)(wl + WO_IN), grow0, gcol0, f_); } }
            { int tid = threadIdx.x; asm volatile("" : "+v"(tid));
              const int half = G / 2;
              if (bx >= half) s5_build_tables((bx - half) * (NWAVES * 64) + tid, (G - half) * NWAVES * 64, tb, (const float*)(ws + WS_LPOW) + (size_t)L * NG * (S5T + 1) * NP * 2,
                                              GIN(I_CRE) + (size_t)L * NG * GC * NP, GIN(I_CIM) + (size_t)L * NG * GC * NP,
                                              (bf16*)(ws + WS_OVL + OV_FT), (bf16*)(ws + WS_OVL + OV_WT), (bf16*)(ws + WS_OVL + OV_GT)); }
            { int tid = threadIdx.x; asm volatile("" : "+v"(tid));
              const int e0 = bx * (NWAVES * 64) + tid, NE = G * NWAVES * 64;
              const float* __restrict__ pp = GIN(I_PP) + (size_t)L * MP * PLE; bf16* __restrict__ pbo = PB;
#pragma unroll 4
              for (int e = e0; e < MP * (PLE / 8); e += NE) { const f32x4 a = *(const f32x4*)(pp + (size_t)e * 8), c = *(const f32x4*)(pp + (size_t)e * 8 + 4);
                  v4u o; o.x = pk2(a[0], a[1]); o.y = pk2(a[2], a[3]); o.z = pk2(c[0], c[1]); o.w = pk2(c[2], c[3]); *(v4u*)(pbo + (size_t)e * 8) = o; }
              const float* psm = GIN(I_PS) + (size_t)L * MS * PLE;
              for (int e = e0; e < MS * (PLE / 8); e += NE) { const f32x4 a = *(const f32x4*)(psm + (size_t)e * 8), c = *(const f32x4*)(psm + (size_t)e * 8 + 4);
                  v4u o; o.x = pk2(a[0], a[1]); o.y = pk2(a[2], a[3]); o.z = pk2(c[0], c[1]); o.w = pk2(c[2], c[3]); *(v4u*)(PB + (size_t)MP * PLE + (size_t)e * 8) = o; }
            }
            }
            if (BOTH(pb + 0)) GRID_BAR();
        }
        if (PHON(2) && IN(pb + 1)) {
            PHASE_PTRS();
            const bool conv_first = ((bx >> 3) & 1) != 0;
#pragma unroll 1
            for (int s_ = 0; s_ < 2; ++s_) {
                if (L == 0 && (s_ == 0) == conv_first) { int tid = threadIdx.x; asm volatile("" : "+v"(tid)); const int lane = tid & 63, wave = __builtin_amdgcn_readfirstlane(tid >> 6);
                    __syncthreads(); p0_convert(args, lds, lane, wave, bx * NWAVES + wave, G * NWAVES, P0_I_LAYER, DEPTH * P0_I_LAYER); __syncthreads(); }
                if (s_ != 0) continue;
            int tid = threadIdx.x; asm volatile("" : "+v"(tid)); const int lane = tid & 63, wave = __builtin_amdgcn_readfirstlane(tid >> 6);
            const float* cre = GIN(I_CRE) + (size_t)L * NG * GC * NP; const float* cim = GIN(I_CIM) + (size_t)L * NG * GC * NP; const float* dsk = GIN(I_DSK) + L * SSMW;
            for (int it = bx; it < NBATCH * NG; it += G) { const int n = it >> 5, g = it & 31;
                s5_prompt_item_mfma(lds, tid, lane, wave, n, g, US, (const bf16*)(ws + WS_OVL + OV_FT) + (size_t)g * S5T * 512, (const bf16*)(ws + WS_OVL + OV_WT) + (size_t)g * 8 * 16 * 512,
                                    (const bf16*)(ws + WS_OVL + OV_GT) + (size_t)g * S5T * 4 * 512, (const float*)(ws + WS_LPOW) + (((size_t)L * NG + g) * (S5T + 1) + S5T) * NP * 2, dsk + g * 16,
                                    YS, GPTR(float, args.out) + O_REP + ((size_t)(L * NBATCH + n) * NG + g) * NP, GPTR(float, args.out) + O_IMP + ((size_t)(L * NBATCH + n) * NG + g) * NP);
            }
            for (int it = bx * NWAVES + wave; it < DECB * NG; it += G * NWAVES) { const int g = it & 31, b = it >> 5;
                s5_sample_wave(lane, b, g, tb, cre, cim, dsk, US, YS, GIN(I_STRE) + (size_t)L * DECB * NG * NP, GIN(I_STIM) + (size_t)L * DECB * NG * NP,
                               GPTR(float, args.out) + O_RES + (size_t)L * DECB * NG * NP, GPTR(float, args.out) + O_IMS + (size_t)L * DECB * NG * NP); }
            __syncthreads();
            for (int it = bx; it < 2 * (MP / CHUNK); it += G)
                gmlp_prompt_item(lds, tid, lane, wave, (size_t)(it >> 1) * CHUNK, VG, UG, VST, (const bf16*)(ws + WS_WSM) + (size_t)L * NH * CHUNK * CHUNK, (const float*)(ws + WS_WSUM) + (size_t)L * NH * CHUNK,
                                 GIN(I_GV) + L * GMW, GIN(I_BV) + L * GMW, GIN(I_BS) + L * NH * CHUNK, YCAT, (float*)(ws + WS_GQ) + (size_t)(it & 1) * MP, (it & 1) * 2);
            }
            if (BOTH(pb + 1)) GRID_BAR();
        }
        if (PHON(3) && IN(pb + 2)) {
            PHASE_PTRS();
            int tid = threadIdx.x; asm volatile("" : "+v"(tid)); const int lane = tid & 63, wave = __builtin_amdgcn_readfirstlane(tid >> 6);
            constexpr int NGLU = (MP / 256) * (SSMW / 256);
            const bool split = G >= NGLU + 128;
            if (!split || bx < NGLU) {
                pg8::Gemm g{YS, (const bf16*)(wl + WO_GLU), MP, SSMW, opq(SSMW)}; pg8::StaticOrder S; S.init(MP, SSMW, split ? NGLU : G, bx);
                pg8::EpiAct<2> E{YCAT, DM, 0, 0, nullptr, GS, YS, GIN(I_BGLU) + L * SSMW, nullptr};
                pg8::gemm_phase<pg8::EpiAct<2>, pg8::StaticOrder, PG8_ALIGN, PG8_SP2>(lds, g, S, E);
            }
            {
                const bf16* wsm = (const bf16*)(ws + WS_WSM) + (size_t)L * NH * CHUNK * CHUNK;
                const float* g_v = GIN(I_GV) + L * GMW; const float* b_v = GIN(I_BV) + L * GMW; const float* b_s = GIN(I_BS) + L * NH * CHUNK;
                if (!split || bx >= NGLU) for (int k_ = 0; k_ < (split ? 2 : (DECB + 32 + G - 1) / G); ++k_) { const int bz = bx - NGLU;
                    int it; if (split) { it = (bz >= 96) ? (k_ == 0 ? 128 + DECB + (bz - 96) : -1) : (k_ == 0 ? 128 + bz : (bz < 32 ? 128 + 96 + bz : -1)); } else it = 128 + bx + k_ * G;
                    if (it < 0 || it >= 128 + DECB + 32) continue;
                    if (it < 128 + DECB) gmlp_sample_item(lds, tid, lane, wave, it - 128, VG, UG, GIN(I_WS) + (size_t)L * NH * CHUNK * CHUNK, g_v, b_v, b_s, YCAT, GPTR(float, args.out) + O_VS + (size_t)L * DECB * DECS * GMW);
                    else {
                        const int grow0 = MP + 16 * (it - 128 - DECB); LAS float* red = (LAS float*)lds;
                        SF_Glu f_{red, grow0, YS, GIN(I_BGLU) + L * SSMW}; small_gemm_tile<512, 1, 8, SSMW, 2, 1>(lds, tid, YS, SSMW, (const bf16*)(wl + WO_GLU), grow0, 0, f_);
                        for (int r4 = 0; r4 < 2; ++r4) { const int row = wave * 2 + r4; const LAS f32x4* rp = (const LAS f32x4*)(red + (size_t)row * 516) + lane; const f32x4 a = rp[0], b2 = rp[64];
                            float sq = ((a[0] * a[0] + a[1] * a[1]) + (a[2] * a[2] + a[3] * a[3])) + ((b2[0] * b2[0] + b2[1] * b2[1]) + (b2[2] * b2[2] + b2[3] * b2[3]));
                            const float r = __builtin_amdgcn_rsqf(wave_sum(sq) * (1.0f / 512.0f) + NORM_EPS);
                            v2u o0, o1; o0.x = pk2(a[0] * r, a[1] * r); o0.y = pk2(a[2] * r, a[3] * r); o1.x = pk2(b2[0] * r, b2[1] * r); o1.y = pk2(b2[2] * r, b2[3] * r);
                            v2u* yp = (v2u*)(YCAT + (size_t)(grow0 + row) * DM) + lane; yp[0] = o0; yp[64] = o1; }
                        __syncthreads();
                    }
                }
            }
            if (BOTH(pb + 2)) GRID_BAR();
        }
        if (PHON(4) && IN(pb + 3)) {
            PHASE_PTRS();
            pg8::Gemm g{YCAT, (const bf16*)(wl + WO_OUT), MP, DM, opq(DM), 0, 0, 0, YCAT + (size_t)MP * DM, DM}; pg8::StaticOrder S; S.init(MP, DM, G, bx);
            pg8::EpiRes<false, true> E{HIN, HB, SB, nullptr, nullptr, 0, (const LAS float*)(lds + RT_OFF), {}, GS, (const float*)(ws + WS_GQ), MP, MP, (LAS float*)(lds + pg8::XR_OFF + 4096)};
            { int t_ = threadIdx.x; asm volatile("" : "+v"(t_)); pg8::Unit u0_; if (S.next(0, u0_) && t_ < 256) { const size_t row = (size_t)u0_.pm * 256 + t_; const float* GQp = (const float*)(ws + WS_GQ);
                E.pre.a = *(const f32x4*)(GS + row * 8); E.pre.b = *(const f32x4*)(GS + row * 8 + 4); E.pre.c = (f32x4){GQp[row], GQp[MP + row], 0.f, 0.f}; } }
            pg8::gemm_phase<pg8::EpiRes<false, true>, pg8::StaticOrder, PG8_ALIGN, PG8_SP2, false, true>(lds, g, S, E);
            if (BOTH(pb + 3)) GRID_BAR();
        }
        if (PHON(5) && IN(pb + 4)) {
            PHASE_PTRS();
            const bool ple_first = ((bx >> 3) & 1) != 0;
#pragma unroll 1
            for (int s_ = 0; s_ < 3; ++s_) {
                if (s_ == 1) {
                    pg8::Gemm g{HB, (const bf16*)(wl + WO_UP), MP, FF, opq(DM), 0, 0, (bx & 7) * 2, HB + (size_t)MP * DM, DM}; pg8::RevOrder S; S.init_rev(MP, FF, G, bx);
                    pg8::EpiAct<1> E{HID, 256, 0, FF / 256, SB, nullptr, nullptr, nullptr, (const LAS float*)(lds + RT_OFF), HID + (size_t)MP * FF, FF, MP};
                    { int t_ = threadIdx.x; asm volatile("" : "+v"(t_)); pg8::Unit u0_; if (S.next(0, u0_) && t_ < 256) E.pre = pg8::rtpre_load(SB, u0_.pm * 256 + t_); }
                    pg8::gemm_phase<pg8::EpiAct<1>, pg8::RevOrder, PG8_ALIGN, PG8_SP2, true, true>(lds, g, S, E);
                } else {
                    if ((s_ == 0) == ple_first) {
                        pg8::Gemm g{PB, (const bf16*)(wl + WO_PLE), MP, DM, opq(PLE), 0, 0, 0, PB + (size_t)MP * PLE, PLE}; pg8::StaticOrder S; S.init(MP, DM, G, bx);
                        pg8::EpiAct<3> E{PL, DM, 0, 0, nullptr, nullptr, nullptr, nullptr, nullptr, PL + (size_t)MP * DM, DM, MP};
                        pg8::gemm_phase<pg8::EpiAct<3>, pg8::StaticOrder, PG8_ALIGN, PG8_SP2, true, true>(lds, g, S, E);
                    }
                }
            }
            if (BOTH(pb + 4)) GRID_BAR();
        }
        if (PHON(6) && IN(pb + 5)) {
            PHASE_PTRS();
            pg8::Gemm g{HID, (const bf16*)(wl + WO_DN), MP, DM, opq(FF), 256, 131072, (bx & 7) * 8, HID + (size_t)MP * FF, FF}; pg8::StaticOrder S; S.init(MP, DM, G, bx);
            pg8::EpiRes<false> E{HB, HB, SA, nullptr, nullptr, 0, nullptr, {}, nullptr, nullptr, 0, MP, (LAS float*)(lds + pg8::XR_OFF + 4096)};
            pg8::gemm_phase<pg8::EpiRes<false>, pg8::StaticOrder, PG8_ALIGN, PG8_SP2, false, true>(lds, g, S, E);
            if (BOTH(pb + 5)) GRID_BAR();
        }
        if (PHON(7) && IN(pb + 6)) {
            PHASE_PTRS();
            pg8::Gemm g{HB, (const bf16*)(wl + WO_PG), MP, DM, opq(DM), 0, 0, (bx & 7) * 2, HB + (size_t)MP * DM, DM}; pg8::StaticOrder S; S.init(MP, DM, G, bx);
            const bool tile_first = ((bx >> 3) & 1) != 0;
            const bool fin = FUSED_FINAL && L == DEPTH - 1;
            if (!fin) {
                pg8::EpiRes<true> E{HB, HOUT7, SB, SA, PL, 0, (const LAS float*)(lds + RT_OFF), {}, nullptr, nullptr, 0, MP, (LAS float*)(lds + pg8::XR_OFF + 4096)};
                { int t_ = threadIdx.x; asm volatile("" : "+v"(t_)); pg8::Unit u0_; if (S.next(0, u0_) && t_ < 256) E.pre = pg8::rtpre_load(SA, u0_.pm * 256 + t_); }
                pg8::gemm_phase<pg8::EpiRes<true>, pg8::StaticOrder, PG8_ALIGN, PG8_SP2, false, true>(lds, g, S, E);
            } else {
                unsigned* ctlw = (unsigned*)(ws + WS_CTL);
                pg8::EpiFin E{HB, SB, SA, PL, (const LAS float*)(lds + RT_OFF), (LAS float*)(lds + RT_OFF) + 1024, out_ + O_Y, GIN(I_GFIN), ctlw + CW_FIN, ctlw + CW_BAR, (unsigned)(DM / 256), lds};
                { int t_ = threadIdx.x; asm volatile("" : "+v"(t_)); pg8::Unit u0_; if (S.next(0, u0_) && t_ < 256) E.pre = pg8::rtpre_load(SA, u0_.pm * 256 + t_); }
#pragma unroll 1
                for (int s_ = 0; s_ < 2; ++s_) {
                    if ((s_ == 0) != tile_first) pg8::gemm_phase<pg8::EpiFin, pg8::StaticOrder, PG8_ALIGN, PG8_SP2, false>(lds, g, S, E);
                    else { int tid = threadIdx.x; asm volatile("" : "+v"(tid)); const int lane = tid & 63, wave = __builtin_amdgcn_readfirstlane(tid >> 6);
                        SAMPLE_TILES_64_PB(HB, DM, (const bf16*)(wl + WO_PG), DM, 4, (SF_Res<true, true>{grow0, gcol0, HB, HOUT7, SB, SA, PL}));
                        for (int t_ = bx; t_ < 256; t_ += G) { const int rb = t_ >> 4;
                            asm volatile("s_waitcnt vmcnt(0)" ::: "memory");
                            __syncthreads();
                            if (tid == 0) {
                                const unsigned old = xb_add(ctlw + CW_FINS + rb * 64, 1u);
                                if (old == 15u) { __builtin_amdgcn_fence(__ATOMIC_ACQUIRE, "agent"); asm volatile("s_waitcnt vmcnt(0)" ::: "memory"); }
                                MISC[16] = (old == 15u) ? 1u : 0u; }
                            __syncthreads();
                            if (MISC[16] != 0u) final_norm_rows(out_ + O_Y, HOUT7, SB, GIN(I_GFIN), MP + 32 * rb, MP + 32 * rb + 32, wave, NWAVES, lane);
                            __syncthreads(); }
                    }
                }
            }
            if (BOTH(pb + 6) && !(FUSED_FINAL && L == DEPTH - 1)) GRID_BAR();
        }
    }
    if (PHON(8) && IN(15) && !FUSED_FINAL) {
        int tid = threadIdx.x; asm volatile("" : "+v"(tid)); const int lane = tid & 63, wave = __builtin_amdgcn_readfirstlane(tid >> 6);
        final_norm_rows(GPTR(float, args.out) + O_Y, (const bf16*)(GPTR(unsigned char, args.ws) + WS_OVL), (const float*)(GPTR(unsigned char, args.ws) + ((DEPTH & 1) ? WS_SSQ1 : WS_SSQ0)), GIN(I_GFIN), 0, M, bx * NWAVES + wave, G * NWAVES, lane);
    }
    asm volatile("s_waitcnt vmcnt(0)" ::: "memory");
#undef IN
#undef BOTH
}

extern "C" void kernel_launch(void* const* d_in, const int* in_sizes, int n_in, void* d_out, int out_size, void* d_ws, size_t ws_size, hipStream_t stream) {
    static int grid = 0;
    if (grid == 0) {
        if (n_in != N_IN || in_sizes[0] != MP * DM || (size_t)out_size != O_END || ws_size < WS_END) {
            fprintf(stderr, "kernel_launch: built for %d inputs, out of %zu floats, >= %zu bytes of workspace; got n_in %d, in0 %d, out %d, ws %zu; nothing launched\n", (int)N_IN, (size_t)O_END, (size_t)WS_END, n_in, n_in > 0 ? in_sizes[0] : -1, out_size, ws_size); grid = -1; return; }
        int dev = 0, cus = 0, per_cu = 0;
        if (hipGetDevice(&dev) != hipSuccess || hipDeviceGetAttribute(&cus, hipDeviceAttributeMultiprocessorCount, dev) != hipSuccess) { fprintf(stderr, "kernel_launch: hipGetDevice / hipDeviceGetAttribute failed\n"); grid = -1; return; }
        if (hipFuncSetAttribute((const void*)hymba_fwd, hipFuncAttributeMaxDynamicSharedMemorySize, LDS_BYTES) != hipSuccess) { fprintf(stderr, "kernel_launch: hipFuncSetAttribute failed\n"); grid = -1; return; }
        if (hipOccupancyMaxActiveBlocksPerMultiprocessor(&per_cu, (const void*)hymba_fwd, NWAVES * 64, LDS_BYTES) != hipSuccess || per_cu < 1)
            fprintf(stderr, "kernel_launch: note: occupancy query reports %d workgroups per CU\n", per_cu);
        (void)hipGetLastError();
        grid = cus;
    }
    if (grid < 0) return;
    if (hipMemsetAsync((char*)d_ws + WS_CTL, 0, CTL_ZERO_BYTES, stream) != hipSuccess) { fprintf(stderr, "kernel_launch: hipMemsetAsync failed\n"); return; }
    Args a{};
    for (int i = 0; i < N_IN; ++i) a.in[i] = (const float*)d_in[i];
    a.out = (float*)d_out; a.ws = (unsigned char*)d_ws;
    for (int li = 0; li < N_LAUNCHES; ++li) {
        a.ph_lo = (N_LAUNCHES == 1) ? 0 : li; a.ph_hi = (N_LAUNCHES == 1) ? NPH : li + 1; a.li = li;
        hipLaunchKernelGGL(hymba_fwd, dim3(grid), dim3(NWAVES * 64), LDS_BYTES, stream, a);
        const hipError_t le = hipPeekAtLastError();
        if (le != hipSuccess) { fprintf(stderr, "kernel_launch: launch %d failed: %s\n", li, hipGetErrorName(le)); break; }
    }
}
```
